# Optimizing an MI355X kernel written in HIP

```python
import jax, jax.numpy as jnp
from jax import lax
import numpy as np

D_MODEL = 1024
BATCH = 2
SEQ = 8192
DEPTH = 4
DEC_BATCH = 128
DEC_SEQ = 1
PAST_LEN = 8192
PAGE_SIZE = 128

N_META = 16
N_A = DEPTH // 2
N_B = DEPTH - N_A
POOL_WINDOWS = (2, 4, 8, 16)
N_POOL_GROUPS = len(POOL_WINDOWS)
POOL_GC = D_MODEL // N_POOL_GROUPS
MAX_POOL = max(POOL_WINDOWS)
POOL_STATE = MAX_POOL - 1
HEAD_DIM = 64
N_HEADS = D_MODEL // HEAD_DIM
N_KV_HEADS = 4
GROUP = N_HEADS // N_KV_HEADS
KV_DIM = N_KV_HEADS * HEAD_DIM
WINDOW = 128
BLOCK = 128
ATTN_SCALE = HEAD_DIM ** -0.5
D_FF = 2816
CONV_W = 3
ALPHA = (2.0 * DEPTH) ** 0.25
BETA = (8.0 * DEPTH) ** -0.25
LN_EPS = 1e-5
NEG = -1e30

kernel_name = "yoco_pool_swa_sink_convffn_step"


def layer_norm(x, g, b):
    xf = x.astype(jnp.float32)
    mu = jnp.mean(xf, axis=-1, keepdims=True)
    var = jnp.mean(jnp.square(xf - mu), axis=-1, keepdims=True)
    y = (xf - mu) * lax.rsqrt(var + LN_EPS) * g.astype(jnp.float32) + b.astype(jnp.float32)
    return y.astype(x.dtype)


def pool_mixer(xs, w_pool, scale):
    L = xs.shape[1]
    xf = xs.astype(jnp.float32)
    cs = jnp.pad(jnp.cumsum(xf, axis=1), ((0, 0), (MAX_POOL, 0), (0, 0)))
    t = jnp.arange(L)
    parts = []
    for gi, w in enumerate(POOL_WINDOWS):
        ch = slice(gi * POOL_GC, (gi + 1) * POOL_GC)
        win = cs[:, MAX_POOL:MAX_POOL + L, ch] - cs[:, MAX_POOL - w:MAX_POOL - w + L, ch]
        cnt = jnp.minimum(w, t + 1).astype(jnp.float32)[None, :, None]
        parts.append(win / cnt - xf[..., ch])
    d = jnp.stack(parts, axis=2).astype(xs.dtype)
    y = jnp.einsum('blgc,gce->blge', d, w_pool).reshape(xs.shape)
    return y * scale


def conv_ffn(xs, prefix, w_in, conv_w, conv_b, w_out):
    S = xs.shape[1]
    gu = xs @ w_in
    g, u = gu[..., :D_FF], gu[..., D_FF:]
    gp = jnp.concatenate([prefix.astype(g.dtype), g], axis=1)
    c = conv_b
    for k in range(CONV_W):
        c = c + gp[:, k:k + S] * conv_w[k]
    h = jax.nn.silu(c) * u
    return h @ w_out, gp[:, -(CONV_W - 1):]


def sink_attention(q, k, v, mask, sinks):
    s = jnp.einsum('...qkgd,...skd->...kgqs', q, k).astype(jnp.float32) * ATTN_SCALE
    s = jnp.where(mask, s, NEG)
    sink = sinks.astype(jnp.float32).reshape(N_KV_HEADS, GROUP, 1, 1)
    m = jnp.maximum(jnp.max(s, axis=-1, keepdims=True), sink)
    e = jnp.exp(s - m)
    den = jnp.sum(e, axis=-1, keepdims=True) + jnp.exp(sink - m)
    p = (e / den).astype(v.dtype)
    return jnp.einsum('...kgqs,...skd->...qkgd', p, v)


def band_blocks(t, pad):
    B = t.shape[0]
    t = jnp.pad(t, ((0, 0), (pad, 0), (0, 0), (0, 0)))
    nb = t.shape[1] // BLOCK
    t = t.reshape(B, nb, BLOCK, N_KV_HEADS, HEAD_DIM)
    prev = jnp.pad(t[:, :-1], ((0, 0), (1, 0), (0, 0), (0, 0), (0, 0)))
    return jnp.concatenate([prev, t], axis=2)


def band_mask(nb, pad):
    n = jnp.arange(nb)[:, None, None]
    i = jnp.arange(BLOCK)[None, :, None]
    j = jnp.arange(2 * BLOCK)[None, None, :]
    qp = n * BLOCK + i
    kp = (n - 1) * BLOCK + j
    return (kp <= qp) & (qp - kp < WINDOW) & (kp >= pad)


def swa_prompt(x, k_band, v_band, mask, pad, w_q, b_q, sinks, w_o, b_o):
    B, L, _ = x.shape
    q = (x @ w_q + b_q).reshape(B, L, N_KV_HEADS, GROUP, HEAD_DIM)
    q = jnp.pad(q, ((0, 0), (pad, 0), (0, 0), (0, 0), (0, 0)))
    Lp = L + pad
    q = q.reshape(B, Lp // BLOCK, BLOCK, N_KV_HEADS, GROUP, HEAD_DIM)
    o = sink_attention(q, k_band, v_band, mask[None, :, None, None], sinks)
    o = o.reshape(B, Lp, N_HEADS * HEAD_DIM)[:, pad:]
    return o @ w_o + b_o


def swa_sample(x, k_all, v_all, mask, w_q, b_q, sinks, w_o, b_o):
    DB, S, _ = x.shape
    q = (x @ w_q + b_q).reshape(DB, S, N_KV_HEADS, GROUP, HEAD_DIM)
    o = sink_attention(q, k_all, v_all, mask[None, None, None], sinks)
    return o.reshape(DB, S, N_HEADS * HEAD_DIM) @ w_o + b_o


def setup_inputs(seed: int = 0) -> dict:
    key = jax.random.key(seed)
    ks = jax.random.split(key, 26)
    nrm = jax.random.normal
    f32 = jnp.float32
    kv_col_scale = jnp.concatenate([jnp.ones((KV_DIM,), f32), jnp.full((KV_DIM,), BETA, f32)])
    return {
        "x_prompt": nrm(ks[0], (BATCH, SEQ, D_MODEL), f32),
        "x_sample": nrm(ks[1], (DEC_BATCH, DEC_SEQ, D_MODEL), f32),
        "state_pool": nrm(ks[2], (N_A, DEC_BATCH, POOL_STATE, D_MODEL), f32),
        "state_conv": nrm(ks[3], (DEPTH, DEC_BATCH, CONV_W - 1, D_FF), f32),
        "state_k_win": nrm(ks[4], (DEC_BATCH, WINDOW, N_KV_HEADS, HEAD_DIM), f32),
        "state_v_win": nrm(ks[5], (DEC_BATCH, WINDOW, N_KV_HEADS, HEAD_DIM), f32),
        "meta_tokens": nrm(ks[6], (N_META, D_MODEL), f32),
        "pool_w": nrm(ks[7], (N_A, N_POOL_GROUPS, POOL_GC, POOL_GC), f32) * (POOL_GC ** -0.5) * BETA,
        "pool_scale": 1.0 + 0.1 * nrm(ks[8], (N_A, D_MODEL), f32),
        "w_kv": nrm(ks[9], (D_MODEL, 2 * KV_DIM), f32) * (D_MODEL ** -0.5) * kv_col_scale,
        "b_kv": 0.02 * nrm(ks[10], (2 * KV_DIM,), f32),
        "attn_w_q": nrm(ks[11], (N_B, D_MODEL, N_HEADS * HEAD_DIM), f32) * (D_MODEL ** -0.5),
        "attn_b_q": 0.02 * nrm(ks[12], (N_B, N_HEADS * HEAD_DIM), f32),
        "attn_sinks": 0.5 * nrm(ks[13], (N_B, N_HEADS), f32),
        "attn_w_o": nrm(ks[14], (N_B, N_HEADS * HEAD_DIM, D_MODEL), f32) * ((N_HEADS * HEAD_DIM) ** -0.5) * BETA,
        "attn_b_o": 0.02 * nrm(ks[15], (N_B, D_MODEL), f32),
        "ffn_w_in": nrm(ks[16], (DEPTH, D_MODEL, 2 * D_FF), f32) * (D_MODEL ** -0.5),
        "ffn_conv_w": nrm(ks[17], (DEPTH, CONV_W, D_FF), f32) * (CONV_W ** -0.5),
        "ffn_conv_b": 0.02 * nrm(ks[18], (DEPTH, D_FF), f32),
        "ffn_w_out": nrm(ks[19], (DEPTH, D_FF, D_MODEL), f32) * (D_FF ** -0.5) * BETA,
        "ln_mix_g": 1.0 + 0.05 * nrm(ks[20], (DEPTH, D_MODEL), f32),
        "ln_mix_b": 0.02 * nrm(ks[21], (DEPTH, D_MODEL), f32),
        "ln_ffn_g": 1.0 + 0.05 * nrm(ks[22], (DEPTH, D_MODEL), f32),
        "ln_ffn_b": 0.02 * nrm(ks[23], (DEPTH, D_MODEL), f32),
    }


def reference(x_prompt, x_sample, state_pool, state_conv, state_k_win, state_v_win,
              meta_tokens, pool_w, pool_scale, w_kv, b_kv,
              attn_w_q, attn_b_q, attn_sinks, attn_w_o, attn_b_o,
              ffn_w_in, ffn_conv_w, ffn_conv_b, ffn_w_out,
              ln_mix_g, ln_mix_b, ln_ffn_g, ln_ffn_b):
    B = x_prompt.shape[0]
    S = x_sample.shape[1]
    meta = jnp.broadcast_to(meta_tokens[None].astype(x_prompt.dtype), (B, N_META, D_MODEL))
    hp = jnp.concatenate([meta, x_prompt], axis=1)
    hs = x_sample
    L = hp.shape[1]
    pad = (-N_META) % BLOCK
    nb = (L + pad) // BLOCK

    new_pool_p, new_pool_s, new_conv_p, new_conv_s = [], [], [], []
    for layer in range(DEPTH):
        if layer < N_A:
            a = layer
            mix_p = pool_mixer(hp, pool_w[a], pool_scale[a])
            ps = jnp.concatenate([state_pool[a].astype(hs.dtype), hs], axis=1)
            mix_s = pool_mixer(ps, pool_w[a], pool_scale[a])[:, -S:]
            new_pool_p.append(hp[:, -POOL_STATE:])
            new_pool_s.append(ps[:, -POOL_STATE:])
        else:
            bi = layer - N_A
            mix_p = swa_prompt(hp, k_band, v_band, mask_p, pad, attn_w_q[bi], attn_b_q[bi],
                               attn_sinks[bi], attn_w_o[bi], attn_b_o[bi])
            mix_s = swa_sample(hs, k_all, v_all, mask_s, attn_w_q[bi], attn_b_q[bi],
                               attn_sinks[bi], attn_w_o[bi], attn_b_o[bi])
        hp = layer_norm(ALPHA * hp + mix_p, ln_mix_g[layer], ln_mix_b[layer])
        hs = layer_norm(ALPHA * hs + mix_s, ln_mix_g[layer], ln_mix_b[layer])

        zero_prefix = jnp.zeros((B, CONV_W - 1, D_FF), hp.dtype)
        f_p, c_p = conv_ffn(hp, zero_prefix, ffn_w_in[layer], ffn_conv_w[layer], ffn_conv_b[layer], ffn_w_out[layer])
        f_s, c_s = conv_ffn(hs, state_conv[layer], ffn_w_in[layer], ffn_conv_w[layer], ffn_conv_b[layer], ffn_w_out[layer])
        new_conv_p.append(c_p)
        new_conv_s.append(c_s)
        hp = layer_norm(ALPHA * hp + f_p, ln_ffn_g[layer], ln_ffn_b[layer])
        hs = layer_norm(ALPHA * hs + f_s, ln_ffn_g[layer], ln_ffn_b[layer])

        if layer == N_A - 1:
            kv_p = (hp @ w_kv + b_kv).reshape(B, L, 2, N_KV_HEADS, HEAD_DIM)
            k_p, v_p = kv_p[:, :, 0], kv_p[:, :, 1]
            new_k_p = k_p[:, -WINDOW:]
            new_v_p = v_p[:, -WINDOW:]
            k_band = band_blocks(k_p, pad)
            v_band = band_blocks(v_p, pad)
            mask_p = band_mask(nb, pad)
            kv_s = (hs @ w_kv + b_kv).reshape(hs.shape[0], S, 2, N_KV_HEADS, HEAD_DIM)
            k_all = jnp.concatenate([state_k_win.astype(hs.dtype), kv_s[:, :, 0]], axis=1)
            v_all = jnp.concatenate([state_v_win.astype(hs.dtype), kv_s[:, :, 1]], axis=1)
            new_k_s = k_all[:, -WINDOW:]
            new_v_s = v_all[:, -WINDOW:]
            qpos = jnp.arange(S)[:, None]
            kpos = (jnp.arange(WINDOW + S) - WINDOW)[None, :]
            mask_s = (kpos <= qpos) & (qpos - kpos < WINDOW)

    y_prompt = hp[:, N_META:]
    y_sample = hs
    return (y_prompt, y_sample,
            jnp.stack(new_pool_p), jnp.stack(new_pool_s),
            jnp.stack(new_conv_p), jnp.stack(new_conv_s),
            new_k_p, new_v_p, new_k_s, new_v_s)
```

```cpp
#include <hip/hip_runtime.h>
#include <hip/hip_cooperative_groups.h>
#include <cstdio>
#include <cstdint>
namespace cg = cooperative_groups;

#define LAS __attribute__((address_space(3)))
typedef unsigned short bf16_t;
typedef short bf16x8 __attribute__((ext_vector_type(8)));
typedef short s16x4 __attribute__((ext_vector_type(4)));
typedef float f32x4 __attribute__((ext_vector_type(4)));
typedef float f32x16 __attribute__((ext_vector_type(16)));
typedef unsigned u32x4 __attribute__((ext_vector_type(4)));
typedef unsigned u32x2 __attribute__((ext_vector_type(2)));

constexpr int D = 1024, FF = 2816, LP = 8208  , NPR = 2 * LP  , NS = 128, NROWS = NPR + NS  ;
constexpr int RA = 16896;
constexpr int MAINROWS = 16384;
constexpr int KVROWS = 16640;
constexpr float ALPHA = 1.6817928305074290f;
constexpr float LN_EPS = 1e-5f;
constexpr float LOG2E = 1.4426950408889634f;

constexpr size_t O_YP = 0, O_YS = O_YP + (size_t)2 * 8192 * 1024, O_PP = O_YS + (size_t)128 * 1024, O_PS = O_PP + (size_t)2 * 2 * 15 * 1024,
                 O_CP = O_PS + (size_t)2 * 128 * 15 * 1024, O_CS = O_CP + (size_t)4 * 2 * 2 * FF, O_KP = O_CS + (size_t)4 * 128 * 2 * FF,
                 O_VP = O_KP + (size_t)2 * 128 * 256, O_KS = O_VP + (size_t)2 * 128 * 256, O_VS = O_KS + (size_t)128 * 128 * 256, O_END = O_VS + (size_t)128 * 128 * 256;

constexpr size_t MiB = 1u << 20;
constexpr size_t WS_WIN = 1 * MiB;
constexpr size_t WS_WOUT = WS_WIN + (size_t)4 * 5632 * 1024 * 2;
constexpr size_t WS_WQ = WS_WOUT + (size_t)4 * 1024 * 2816 * 2;
constexpr size_t WS_WO = WS_WQ + (size_t)2 * 1024 * 1024 * 2;
constexpr size_t WS_WKV = WS_WO + (size_t)2 * 1024 * 1024 * 2;
constexpr size_t WS_WPOOL = WS_WKV + (size_t)512 * 1024 * 2;
constexpr size_t WS_HF = WS_WPOOL + (size_t)8 * 256 * 256 * 2;
constexpr size_t WS_HB = WS_HF + (size_t)RA * 1024 * 4;
constexpr size_t WS_HMID = WS_HB + (size_t)(RA + 8) * 1024 * 2;
constexpr size_t WS_Q = WS_HMID;
constexpr size_t WS_O = WS_HMID + (size_t)RA * 1024 * 2;
constexpr size_t WS_KB = WS_HMID + (size_t)RA * FF * 2;
constexpr size_t WS_VT = WS_KB + (size_t)KVROWS * 256 * 2;
constexpr size_t WS_END = WS_VT + (size_t)KVROWS * 256 * 2;
static_assert(WS_O + (size_t)RA * 1024 * 2 <= WS_KB, "overlay");

constexpr int STAGE_LDS = 131072, EXCH_OFF = STAGE_LDS, LDS_BYTES = 147456;

__device__ __forceinline__ unsigned f2bf(float f) { unsigned u = __builtin_bit_cast(unsigned, f); return (u + 0x7fffu + ((u >> 16) & 1u)) >> 16; }
__device__ __forceinline__ unsigned pk2(float lo, float hi) { return f2bf(lo) | (f2bf(hi) << 16); }
__device__ __forceinline__ float bf2f(bf16_t v) { return __builtin_bit_cast(float, (unsigned)v << 16); }
__device__ __forceinline__ float wave_sum(float v) {
#pragma unroll
    for (int o = 1; o < 64; o <<= 1) v += __shfl_xor(v, o);
    return v;
}
__device__ __forceinline__ float wave_max(float v) {
#pragma unroll
    for (int o = 1; o < 64; o <<= 1) v = fmaxf(v, __shfl_xor(v, o));
    return v;
}
__device__ __forceinline__ float rdlane(float v, int l) { return __builtin_bit_cast(float, __builtin_amdgcn_readlane(__builtin_bit_cast(int, v), l)); }

__device__ __forceinline__ int launder_v(int x) { asm volatile("" : "+v"(x)); return x; }
__device__ __forceinline__ int launder_s(int x) { asm volatile("" : "+s"(x)); return x; }
namespace pg8 {
constexpr int BM = 256, BK = 64, HALF = 128, HTB = HALF * BK * 2, NXCD = 8, WGM = 8;
__device__ __forceinline__ int lds_byte(int r, int c) { const int st = (r >> 4) * 2 + (c >> 5), rr = r & 15, cc = c & 31, ob = rr * 64 + cc * 2; return st * 1024 + (ob ^ (((ob >> 9) & 1) << 5)); }
__device__ __forceinline__ void stage_rc(int b, int& R, int& C) { const int st = b / 1024, sb = b % 1024, swz = sb ^ (((sb >> 9) & 1) << 5); R = (st >> 1) * 16 + swz / 64; C = (st & 1) * 32 + (swz % 64) / 2; }
struct Unit { int pm, pn; };
struct Gemm { const bf16_t* A; const bf16_t* Bt; int lda, ldb, K, a_rows, a_pn_bytes; };
struct StaticOrder {
    int nM, nN, nwg, G, c;
    __device__ void init(int nM_, int nN_, int G_, int c_) { nM = nM_; nN = nN_; nwg = nM * nN; G = G_; c = c_; }
    __device__ bool next(int i, Unit& u) const {
        const long L = (long)i * G + c; if (L >= nwg) return false;
        int wgid = (int)L; { const int q = nwg / NXCD, r = nwg % NXCD, xcd = wgid % NXCD, off = wgid / NXCD; wgid = (xcd < r ? xcd * (q + 1) : r * (q + 1) + (xcd - r) * q) + off; }
        const int nig = WGM * nN, gid = wgid / nig, fm = gid * WGM, gsz = (nM - fm) < WGM ? (nM - fm) : WGM;
        u.pm = fm + ((wgid % nig) % gsz); u.pn = (wgid % nig) / gsz; return true;
    }
};

template <class Epi, class Sched>
__device__ __forceinline__ void gemm_phase(LAS unsigned char* lds, const Gemm g, const Sched& S, const Epi& E) {
    const int tid = launder_v(threadIdx.x), wid = __builtin_amdgcn_readfirstlane(tid >> 6), lane = tid & 63, wr = wid >> 2, wc = wid & 3, fr = lane & 15, fq = lane >> 4;
    const int K = g.K, nt = K / BK;
    unsigned voffA[2], voffB[2];
#pragma unroll
    for (int i = 0; i < 2; ++i) { int R, C; stage_rc(tid * 16 + i * 8192, R, C); voffA[i] = (unsigned)(R * g.lda + C) * 2u; voffB[i] = (unsigned)(R * g.ldb + C) * 2u; }
    const size_t kstep = (size_t)(BK * 2);
    const size_t hstepA = (size_t)HALF * g.lda * 2, hstepB = (size_t)HALF * g.ldb * 2;
    const size_t tstepA = (size_t)g.a_rows * g.lda * 2, tstepB = (size_t)BM * g.ldb * 2;
    const unsigned ldsw = (unsigned)wid * 1024u;
    const int aoff = lds_byte(wr * 64 + fr, fq * 8), boff = lds_byte(wc * 32 + fr, fq * 8);
#define PG8_SA(b, h) (((b) * 2 + (h)) * HTB)
#define PG8_SB(b, h) ((4 + (b) * 2 + (h)) * HTB)
#define PG8_STAGE(bufoff, gbase, voff) do { _Pragma("unroll") for (int _i = 0; _i < 2; ++_i) \
        __builtin_amdgcn_global_load_lds((const unsigned*)((const char*)(gbase) + (voff)[_i]), (LAS unsigned*)(lds + (bufoff) + ldsw + _i * 8192), 16, 0, 0); } while (0)
#define PG8_LDA(dst, b, h) do { _Pragma("unroll") for (int m = 0; m < 4; ++m) _Pragma("unroll") for (int k = 0; k < 2; ++k) dst[m][k] = *(const LAS bf16x8*)(lds + PG8_SA(b, h) + aoff + m * 2048 + k * 1024); } while (0)
#define PG8_LDB(dst, b, h) do { _Pragma("unroll") for (int n = 0; n < 2; ++n) _Pragma("unroll") for (int k = 0; k < 2; ++k) dst[n][k] = *(const LAS bf16x8*)(lds + PG8_SB(b, h) + boff + n * 2048 + k * 1024); } while (0)
#define PG8_MMA(ai, bj, At, Bt) do { __builtin_amdgcn_s_setprio(1); _Pragma("unroll") for (int m = 0; m < 4; ++m) _Pragma("unroll") for (int n = 0; n < 2; ++n) _Pragma("unroll") for (int k = 0; k < 2; ++k) \
        acc[ai][bj][m][n] = __builtin_amdgcn_mfma_f32_16x16x32_bf16(Bt[n][k], At[m][k], acc[ai][bj][m][n], 0, 0, 0); __builtin_amdgcn_s_setprio(0); } while (0)
#define PG8_WAIT_V(n) asm volatile("s_waitcnt vmcnt(" #n ")" ::: "memory")
#define PG8_WAIT_L(n) asm volatile("s_waitcnt lgkmcnt(" #n ")" ::: "memory")
#define PG8_BAR __builtin_amdgcn_s_barrier()
#define PG8_SCHED __builtin_amdgcn_sched_barrier(0)
    Unit cur, nxt; int ui = 0;
    if (!S.next(0, cur)) return;
    f32x4 acc[2][2][4][2];
#pragma unroll
    for (int a = 0; a < 2; ++a)
#pragma unroll
        for (int b = 0; b < 2; ++b)
#pragma unroll
            for (int m = 0; m < 4; ++m)
#pragma unroll
                for (int n = 0; n < 2; ++n) acc[a][b][m][n] = (f32x4){0.f, 0.f, 0.f, 0.f};
    bf16x8 At[4][2], B0[2][2], B1[2][2];
    const char* cA = (const char*)g.A + (size_t)cur.pm * tstepA + (size_t)cur.pn * g.a_pn_bytes; const char* cB = (const char*)g.Bt + (size_t)cur.pn * tstepB;
    PG8_STAGE(PG8_SB(0, 0), cB, voffB); PG8_STAGE(PG8_SB(0, 1), cB + hstepB, voffB); PG8_STAGE(PG8_SA(0, 0), cA, voffA); PG8_STAGE(PG8_SA(0, 1), cA + hstepA, voffA);
    if (wr == 1) PG8_BAR;
    PG8_WAIT_V(2); PG8_BAR;
    PG8_STAGE(PG8_SB(1, 0), cB + kstep, voffB); PG8_STAGE(PG8_SA(1, 0), cA + kstep, voffA); PG8_STAGE(PG8_SB(1, 1), cB + hstepB + kstep, voffB);
    PG8_WAIT_V(6); PG8_BAR;
    for (;;) {
        const bool has_next = S.next(ui + 1, nxt);
        const char* nA = has_next ? (const char*)g.A + (size_t)nxt.pm * tstepA + (size_t)nxt.pn * g.a_pn_bytes : cA; const char* nB = has_next ? (const char*)g.Bt + (size_t)nxt.pn * tstepB : cB;
        for (int t = 0; t < nt; t += 2) {
            const bool last = (t == nt - 2);
            const char* a1 = cA + (size_t)(t + 1) * kstep;
            const char* a2 = last ? nA : cA + (size_t)(t + 2) * kstep; const char* b2 = last ? nB : cB + (size_t)(t + 2) * kstep;
            const char* a3 = a2 + kstep; const char* b3 = b2 + kstep;
            PG8_LDB(B0, 0, 0); PG8_LDB(B1, 0, 1); PG8_SCHED; PG8_LDA(At, 0, 0); PG8_STAGE(PG8_SA(1, 1), a1 + hstepA, voffA);
            PG8_WAIT_V(8); PG8_WAIT_L(0); PG8_BAR; PG8_MMA(0, 0, At, B0); PG8_MMA(0, 1, At, B1); PG8_BAR; PG8_SCHED;
            PG8_LDA(At, 0, 1); PG8_STAGE(PG8_SB(0, 0), b2, voffB); PG8_STAGE(PG8_SB(0, 1), b2 + hstepB, voffB); PG8_STAGE(PG8_SA(0, 0), a2, voffA);
            PG8_WAIT_V(8); PG8_WAIT_L(0); PG8_BAR; PG8_MMA(1, 0, At, B0); PG8_MMA(1, 1, At, B1); PG8_BAR; PG8_SCHED;
            PG8_LDB(B0, 1, 0); PG8_LDB(B1, 1, 1); PG8_SCHED; PG8_LDA(At, 1, 0); PG8_STAGE(PG8_SA(0, 1), a2 + hstepA, voffA);
            PG8_WAIT_V(8); PG8_WAIT_L(0); PG8_BAR; PG8_MMA(0, 0, At, B0); PG8_MMA(0, 1, At, B1); PG8_BAR; PG8_SCHED;
            PG8_LDA(At, 1, 1); PG8_STAGE(PG8_SB(1, 0), b3, voffB); PG8_STAGE(PG8_SB(1, 1), b3 + hstepB, voffB); PG8_STAGE(PG8_SA(1, 0), a3, voffA);
            PG8_WAIT_V(8); PG8_WAIT_L(0); PG8_BAR; PG8_MMA(1, 0, At, B0); PG8_MMA(1, 1, At, B1); PG8_BAR; PG8_SCHED;
        }
        if (wr == 0) PG8_BAR;
        E(acc, cur, wr, wc, fr, fq);
        if (!has_next) break;
#pragma unroll
        for (int a = 0; a < 2; ++a)
#pragma unroll
            for (int b = 0; b < 2; ++b)
#pragma unroll
                for (int m = 0; m < 4; ++m)
#pragma unroll
                    for (int n = 0; n < 2; ++n) acc[a][b][m][n] = (f32x4){0.f, 0.f, 0.f, 0.f};
        cur = nxt; cA = nA; cB = nB; ++ui;
        if (wr == 1) PG8_BAR;
    }
    PG8_WAIT_V(0);
    PG8_BAR;
#undef PG8_SA
#undef PG8_SB
#undef PG8_STAGE
#undef PG8_LDA
#undef PG8_LDB
#undef PG8_MMA
#undef PG8_WAIT_V
#undef PG8_WAIT_L
#undef PG8_BAR
#undef PG8_SCHED
}
}

typedef f32x4 AccT[2][2][4][2];

struct EpiResid {
    float* hf; const float* colscale; const float* bias;
    __device__ __forceinline__ void operator()(const AccT& acc, const pg8::Unit& u, int wr, int wc, int fr_, int fq_) const {
        const int fr = launder_v(fr_), fq = launder_v(fq_);
#pragma unroll
        for (int bj = 0; bj < 2; ++bj)
#pragma unroll
            for (int n = 0; n < 2; ++n) {
                const int c = u.pn * 256 + bj * 128 + wc * 32 + n * 16 + fq * 4;
                const f32x4 cs = colscale ? *(const f32x4*)(colscale + c) : (f32x4){1.f, 1.f, 1.f, 1.f};
                const f32x4 bv = bias ? *(const f32x4*)(bias + c) : (f32x4){0.f, 0.f, 0.f, 0.f};
#pragma unroll
                for (int ai = 0; ai < 2; ++ai)
#pragma unroll
                    for (int m = 0; m < 4; ++m) {
                        const int r = u.pm * 256 + ai * 128 + wr * 64 + m * 16 + fr;
                        f32x4* p = (f32x4*)(hf + (size_t)r * D + c);
                        *p = *p * ALPHA + (acc[ai][bj][m][n] * cs + bv);
                    }
            }
    }
    __device__ __forceinline__ void elem(int r, int c, float v) const {
        const float cs = colscale ? colscale[c] : 1.f, bv = bias ? bias[c] : 0.f;
        float* p = hf + (size_t)r * D + c; *p = *p * ALPHA + (v * cs + bv);
    }
};
struct EpiQ {
    bf16_t* Q; const float* bq;
    __device__ __forceinline__ void operator()(const AccT& acc, const pg8::Unit& u, int wr, int wc, int fr_, int fq_) const {
        const int fr = launder_v(fr_), fq = launder_v(fq_);
#pragma unroll
        for (int bj = 0; bj < 2; ++bj)
#pragma unroll
            for (int n = 0; n < 2; ++n) {
                const int c = u.pn * 256 + bj * 128 + wc * 32 + n * 16 + fq * 4;
                const f32x4 bv = *(const f32x4*)(bq + c);
#pragma unroll
                for (int ai = 0; ai < 2; ++ai)
#pragma unroll
                    for (int m = 0; m < 4; ++m) {
                        const int r = u.pm * 256 + ai * 128 + wr * 64 + m * 16 + fr;
                        const f32x4 v = (acc[ai][bj][m][n] + bv) * 0.125f;
                        u32x2 w; w.x = pk2(v[0], v[1]); w.y = pk2(v[2], v[3]);
                        *(u32x2*)(Q + (size_t)r * D + c) = w;
                    }
            }
    }
    __device__ __forceinline__ void elem(int r, int c, float v) const { Q[(size_t)r * D + c] = (bf16_t)f2bf((v + bq[c]) * 0.125f); }
};
struct EpiK {
    bf16_t* KB; const float* bk; float* out;
    __device__ __forceinline__ void operator()(const AccT& acc, const pg8::Unit& u, int wr, int wc, int fr_, int fq_) const {
        const int fr = launder_v(fr_), fq = launder_v(fq_);
#pragma unroll
        for (int bj = 0; bj < 2; ++bj)
#pragma unroll
            for (int n = 0; n < 2; ++n) {
                const int c = bj * 128 + wc * 32 + n * 16 + fq * 4;
                const f32x4 bv = *(const f32x4*)(bk + c);
#pragma unroll
                for (int ai = 0; ai < 2; ++ai)
#pragma unroll
                    for (int m = 0; m < 4; ++m) {
                        const int r = u.pm * 256 + ai * 128 + wr * 64 + m * 16 + fr;
                        const f32x4 v = acc[ai][bj][m][n] + bv;
                        u32x2 w; w.x = pk2(v[0], v[1]); w.y = pk2(v[2], v[3]);
                        *(u32x2*)(KB + (size_t)r * 256 + c) = w;
                        if (r < NPR) { const int b = r >= LP ? 1 : 0, p = r - b * LP; if (p >= LP - 128) *(f32x4*)(out + O_KP + ((size_t)(b * 128 + p - (LP - 128))) * 256 + c) = v; }
                        else if (r < NROWS) { *(f32x4*)(out + O_KS + ((size_t)(r - NPR) * 128 + 127) * 256 + c) = v; }
                    }
            }
    }
};
struct EpiVt {
    bf16_t* VT; const float* bv; float* out;
    __device__ __forceinline__ void operator()(const AccT& acc, const pg8::Unit& u, int wr, int wc, int fr_, int fq_) const {
        const int fr = launder_v(fr_), fq = launder_v(fq_);
#pragma unroll
        for (int ai = 0; ai < 2; ++ai)
#pragma unroll
            for (int m = 0; m < 4; ++m) {
                const int d = ai * 128 + wr * 64 + m * 16 + fr;
                const float b = bv[d];
#pragma unroll
                for (int bj = 0; bj < 2; ++bj)
#pragma unroll
                    for (int n = 0; n < 2; ++n) {
                        const int c = u.pn * 256 + bj * 128 + wc * 32 + n * 16 + fq * 4;
                        const f32x4 v = acc[ai][bj][m][n] + b;
                        u32x2 w; w.x = pk2(v[0], v[1]); w.y = pk2(v[2], v[3]);
                        *(u32x2*)(VT + (size_t)d * KVROWS + c) = w;
#pragma unroll
                        for (int j = 0; j < 4; ++j) { const int r = c + j;
                            if (r < NPR) { const int bb = r >= LP ? 1 : 0, p = r - bb * LP; if (p >= LP - 128) out[O_VP + ((size_t)(bb * 128 + p - (LP - 128))) * 256 + d] = v[j]; }
                            else if (r < NROWS) out[O_VS + ((size_t)(r - NPR) * 128 + 127) * 256 + d] = v[j]; }
                    }
            }
    }
};
struct EpiFfnIn {
    bf16_t* hmid; const float* convw; const float* convb; const float* state_conv; float* out_cp; float* out_cs; LAS float* exch;
    __device__ __forceinline__ void operator()(const AccT& acc, const pg8::Unit& u, int wr, int wc, int fr_, int fq_) const {
        const int fr = launder_v(fr_), fq = launder_v(fq_);
        const int lane = fq * 16 + fr;
        if (fr >= 14) {
#pragma unroll
            for (int ai = 0; ai < 2; ++ai)
#pragma unroll
                for (int n = 0; n < 2; ++n) *(LAS f32x4*)(exch + ((ai * 2 + wr) * 2 + (fr - 14)) * 128 + wc * 32 + n * 16 + fq * 4) = acc[ai][0][3][n];
        }
        asm volatile("s_waitcnt lgkmcnt(0)" ::: "memory"); __builtin_amdgcn_s_barrier(); asm volatile("" ::: "memory");
        const int src1 = (lane & 48) | ((fr + 15) & 15), src2 = (lane & 48) | ((fr + 14) & 15);
#pragma unroll
        for (int n = 0; n < 2; ++n) {
            const int ff = u.pn * 128 + wc * 32 + n * 16 + fq * 4;
            const f32x4 w0 = *(const f32x4*)(convw + ff), w1 = *(const f32x4*)(convw + FF + ff), w2 = *(const f32x4*)(convw + 2 * FF + ff), cb = *(const f32x4*)(convb + ff);
#pragma unroll
            for (int ai = 0; ai < 2; ++ai) {
                const int pbi = ai * 2 + wr - 1;
                f32x4 e14 = (f32x4){0.f, 0.f, 0.f, 0.f}, e15 = e14;
                if (pbi >= 0) { e14 = *(const LAS f32x4*)(exch + (pbi * 2 + 0) * 128 + wc * 32 + n * 16 + fq * 4); e15 = *(const LAS f32x4*)(exch + (pbi * 2 + 1) * 128 + wc * 32 + n * 16 + fq * 4); }
#pragma unroll
                for (int m = 0; m < 4; ++m) {
                    const int r_loc = ai * 128 + wr * 64 + m * 16 + fr; const int R = u.pm * 254 - 2 + r_loc;
                    const f32x4 g0 = acc[ai][0][m][n], uu = acc[ai][1][m][n];
                    f32x4 x1, x2;
                    if (m == 0) { x1 = g0; x2 = g0; } else { const f32x4 gp = acc[ai][0][m == 0 ? 0 : m - 1][n]; x1 = (fr == 15) ? gp : g0; x2 = (fr >= 14) ? gp : g0; }
                    f32x4 p1, p2;
#pragma unroll
                    for (int j = 0; j < 4; ++j) { p1[j] = __shfl(x1[j], src1); p2[j] = __shfl(x2[j], src2); }
                    if (m == 0) { if (fr == 0) { p1 = e15; p2 = e14; } else if (fr == 1) { p2 = e15; } }
                    const bool valid = (r_loc >= 2) && (R < NROWS);
                    if (valid) {
                        if (R < NPR) {
                            const int b = R >= LP ? 1 : 0, p = R - b * LP;
                            if (p < 1) p1 = (f32x4){0.f, 0.f, 0.f, 0.f};
                            if (p < 2) p2 = (f32x4){0.f, 0.f, 0.f, 0.f};
                            if (p >= LP - 2) *(f32x4*)(out_cp + ((size_t)(b * 2 + (p - (LP - 2)))) * FF + ff) = g0;
                        } else {
                            const int s = R - NPR;
                            p2 = *(const f32x4*)(state_conv + ((size_t)s * 2 + 0) * FF + ff);
                            p1 = *(const f32x4*)(state_conv + ((size_t)s * 2 + 1) * FF + ff);
                            *(f32x4*)(out_cs + ((size_t)s * 2 + 0) * FF + ff) = p1;
                            *(f32x4*)(out_cs + ((size_t)s * 2 + 1) * FF + ff) = g0;
                        }
                        const f32x4 c = cb + w0 * p2 + w1 * p1 + w2 * g0;
                        f32x4 h;
#pragma unroll
                        for (int j = 0; j < 4; ++j) h[j] = c[j] * __builtin_amdgcn_rcpf(1.f + __builtin_amdgcn_exp2f(-c[j] * LOG2E)) * uu[j];
                        u32x2 w; w.x = pk2(h[0], h[1]); w.y = pk2(h[2], h[3]);
                        *(u32x2*)(hmid + (size_t)R * FF + ff) = w;
                    }
                }
            }
        }
    }
};

template <class Epi>
__device__ __forceinline__ void small_piece(LAS unsigned char* lds, const bf16_t* A, int lda, const bf16_t* Bt, int ldb, int K, int row0, int col0, const Epi& E) {
    const int tid = launder_v(threadIdx.x), wid = __builtin_amdgcn_readfirstlane(tid >> 6), lane = tid & 63, fr = lane & 15, fq = lane >> 4;
    const int kw = K / 8, k0 = wid * kw;
    f32x4 acc[4];
#pragma unroll
    for (int n = 0; n < 4; ++n) acc[n] = (f32x4){0.f, 0.f, 0.f, 0.f};
    for (int ks = 0; ks < kw; ks += 32) {
        const bf16x8 a = *(const bf16x8*)(A + (size_t)fr * lda + k0 + ks + fq * 8);
#pragma unroll
        for (int n = 0; n < 4; ++n) {
            const bf16x8 b = *(const bf16x8*)(Bt + (size_t)(n * 16 + fr) * ldb + k0 + ks + fq * 8);
            acc[n] = __builtin_amdgcn_mfma_f32_16x16x32_bf16(b, a, acc[n], 0, 0, 0);
        }
    }
    LAS float* red = (LAS float*)lds;
#pragma unroll
    for (int n = 0; n < 4; ++n) *(LAS f32x4*)(red + wid * 1024 + fr * 64 + n * 16 + fq * 4) = acc[n];
    __syncthreads();
#pragma unroll
    for (int i = 0; i < 2; ++i) {
        const int idx = tid + i * 512; float s = 0.f;
#pragma unroll
        for (int w = 0; w < 8; ++w) s += red[w * 1024 + idx];
        E.elem(row0 + (idx >> 6), col0 + (idx & 63), s);
    }
    __syncthreads();
}

struct Args { const float* in[24]; float* out; unsigned char* ws; };

__device__ __forceinline__ void transpose_item(const float* W, int K, int N, bf16_t* WT, int k0, int n0, int drow0, LAS float* scr, int lane) {
#pragma unroll 8
    for (int i = 0; i < 32; ++i) { const int kk = 2 * i + (lane >> 5); scr[kk * 33 + (lane & 31)] = W[(size_t)(k0 + kk) * N + n0 + (lane & 31)]; }
    asm volatile("s_waitcnt lgkmcnt(0)" ::: "memory");
    const int c = lane & 7;
#pragma unroll
    for (int j = 0; j < 4; ++j) { const int n = (lane >> 3) + 8 * j; const LAS float* s = scr + (8 * c) * 33 + n;
        u32x4 o; o.x = pk2(s[0 * 33], s[1 * 33]); o.y = pk2(s[2 * 33], s[3 * 33]); o.z = pk2(s[4 * 33], s[5 * 33]); o.w = pk2(s[6 * 33], s[7 * 33]);
        *(u32x4*)(WT + (size_t)(drow0 + n) * K + k0 + 8 * c) = o; }
    asm volatile("s_waitcnt lgkmcnt(0)" ::: "memory");
}
__device__ __forceinline__ void transpose_matrix_item(const float* W, int K, int N, bf16_t* WT, int item, LAS float* scr, int lane, bool ffn_in) {
    const int nblk = N / 32, kb = item / nblk, nb = item % nblk, n0 = 32 * nb;
    int drow0 = n0;
    if (ffn_in) { const int isu = n0 >= FF ? 1 : 0, ff = n0 - isu * FF; drow0 = (ff >> 7) * 256 + isu * 128 + (ff & 127); }
    transpose_item(W, K, N, WT, 64 * kb, n0, drow0, scr, lane);
}

__global__ void __launch_bounds__(512, 2) mega(Args a) {
    extern __shared__ __attribute__((aligned(16))) unsigned char lds_raw[];
    LAS unsigned char* lds = (LAS unsigned char*)lds_raw;
    cg::grid_group grid = cg::this_grid();
    const int G = gridDim.x, bx = blockIdx.x, NGW = G * 8, NGT = G * 512;
#define PHASE_IDS const int tid = launder_v(threadIdx.x), lane = tid & 63, wave = __builtin_amdgcn_readfirstlane(tid >> 6), gw = bx * 8 + wave, gt = bx * 512 + tid; (void)lane; (void)gw; (void)gt; (void)wave
    unsigned char* ws = a.ws; float* out = a.out;
    const float* x_prompt = a.in[0]; const float* x_sample = a.in[1]; const float* state_pool = a.in[2]; const float* state_conv = a.in[3];
    const float* state_k = a.in[4]; const float* state_v = a.in[5]; const float* meta = a.in[6]; const float* pool_w = a.in[7]; const float* pool_scale = a.in[8];
    const float* w_kv = a.in[9]; const float* b_kv = a.in[10]; const float* attn_wq = a.in[11]; const float* attn_bq = a.in[12]; const float* attn_sinks = a.in[13];
    const float* attn_wo = a.in[14]; const float* attn_bo = a.in[15]; const float* ffn_win = a.in[16]; const float* ffn_convw = a.in[17]; const float* ffn_convb = a.in[18];
    const float* ffn_wout = a.in[19]; const float* ln_mix_g = a.in[20]; const float* ln_mix_b = a.in[21]; const float* ln_ffn_g = a.in[22]; const float* ln_ffn_b = a.in[23];
    bf16_t* W_IN = (bf16_t*)(ws + WS_WIN); bf16_t* W_OUT = (bf16_t*)(ws + WS_WOUT); bf16_t* W_Q = (bf16_t*)(ws + WS_WQ); bf16_t* W_O = (bf16_t*)(ws + WS_WO);
    bf16_t* W_KV = (bf16_t*)(ws + WS_WKV); bf16_t* W_POOL = (bf16_t*)(ws + WS_WPOOL);
    float* HF = (float*)(ws + WS_HF); bf16_t* HB = (bf16_t*)(ws + WS_HB) + (size_t)8 * D; bf16_t* HMID = (bf16_t*)(ws + WS_HMID);
    bf16_t* QB = (bf16_t*)(ws + WS_Q); bf16_t* OB = (bf16_t*)(ws + WS_O); bf16_t* KB = (bf16_t*)(ws + WS_KB); bf16_t* VT = (bf16_t*)(ws + WS_VT);

    {
        PHASE_IDS;
        LAS float* scr = (LAS float*)(lds + wave * 16384);
        constexpr int I_IN = (1024 / 64) * (5632 / 32), I_OUT = (2816 / 64) * (1024 / 32), I_SQ = 16 * 32, I_KV = 16 * 16, I_PL = 4 * 8;
        constexpr int NITEMS = 4 * I_IN + 4 * I_OUT + 4 * I_SQ + I_KV + 8 * I_PL;
        for (int it = gw; it < NITEMS; it += NGW) {
            int r = it;
            if (r < 4 * I_IN) { const int l = r / I_IN; transpose_matrix_item(ffn_win + (size_t)l * 1024 * 5632, 1024, 5632, W_IN + (size_t)l * 5632 * 1024, r % I_IN, scr, lane, true); continue; } r -= 4 * I_IN;
            if (r < 4 * I_OUT) { const int l = r / I_OUT; transpose_matrix_item(ffn_wout + (size_t)l * 2816 * 1024, 2816, 1024, W_OUT + (size_t)l * 1024 * 2816, r % I_OUT, scr, lane, false); continue; } r -= 4 * I_OUT;
            if (r < 2 * I_SQ) { const int l = r / I_SQ; transpose_matrix_item(attn_wq + (size_t)l * 1024 * 1024, 1024, 1024, W_Q + (size_t)l * 1024 * 1024, r % I_SQ, scr, lane, false); continue; } r -= 2 * I_SQ;
            if (r < 2 * I_SQ) { const int l = r / I_SQ; transpose_matrix_item(attn_wo + (size_t)l * 1024 * 1024, 1024, 1024, W_O + (size_t)l * 1024 * 1024, r % I_SQ, scr, lane, false); continue; } r -= 2 * I_SQ;
            if (r < I_KV) { transpose_matrix_item(w_kv, 1024, 512, W_KV, r, scr, lane, false); continue; } r -= I_KV;
            { const int l = r / I_PL; transpose_matrix_item(pool_w + (size_t)l * 65536, 256, 256, W_POOL + (size_t)l * 65536, r % I_PL, scr, lane, false); }
        }
        for (int row = gw; row < NROWS; row += NGW) {
            const float* src;
            if (row < NPR) { const int b = row >= LP ? 1 : 0, p = row - b * LP; src = p < 16 ? meta + (size_t)p * D : x_prompt + ((size_t)b * 8192 + (p - 16)) * D; }
            else src = x_sample + (size_t)(row - NPR) * D;
#pragma unroll
            for (int j = 0; j < 4; ++j) *((f32x4*)(HF + (size_t)row * D) + lane + 64 * j) = *((const f32x4*)src + lane + 64 * j);
        }
        for (int i = gt; i < 128 * 127 * 64; i += NGT) {
            const int c4 = i & 63, rr = (i >> 6) % 127, s = (i >> 6) / 127;
            *((f32x4*)(out + O_KS + ((size_t)s * 128 + rr) * 256) + c4) = *((const f32x4*)(state_k + ((size_t)s * 128 + rr + 1) * 256) + c4);
            *((f32x4*)(out + O_VS + ((size_t)s * 128 + rr) * 256) + c4) = *((const f32x4*)(state_v + ((size_t)s * 128 + rr + 1) * 256) + c4);
        }
    }
    grid.sync();

#pragma nounroll
    for (int layer_ = 0; layer_ < 4; ++layer_) {
        const int layer = launder_s(layer_);
        if (layer < 2) {
            PHASE_IDS;
            const float* sp = state_pool + (size_t)layer * 128 * 15 * D;
            for (int i = gt; i < NROWS * 256; i += NGT) {
                const int row = i >> 8, c4 = i & 255, gi = c4 >> 6, w = 2 << gi;
                const f32x4 x = *((const f32x4*)(HF + (size_t)row * D) + c4);
                f32x4 sum = x; int cnt;
                if (row < NPR) {
                    const int b = row >= LP ? 1 : 0, p = row - b * LP; cnt = (p + 1) < w ? (p + 1) : w;
                    for (int k = 1; k < cnt; ++k) sum += *((const f32x4*)(HF + (size_t)(row - k) * D) + c4);
                    if (p >= LP - 15) *((f32x4*)(out + O_PP + (((size_t)layer * 2 + b) * 15 + (p - (LP - 15))) * D) + c4) = x;
                } else {
                    const int s = row - NPR; cnt = w;
                    for (int k = 1; k < w; ++k) sum += *((const f32x4*)(sp + ((size_t)s * 15 + (15 - k)) * D) + c4);
                    float* op = out + O_PS + (((size_t)layer * 128 + s) * 15) * D;
                    *((f32x4*)(op + (size_t)14 * D) + c4) = x;
                    for (int k = 0; k < 14; ++k) *((f32x4*)(op + (size_t)k * D) + c4) = *((const f32x4*)(sp + ((size_t)s * 15 + k + 1) * D) + c4);
                }
                const f32x4 dd = sum * (1.0f / (float)cnt) - x;
                u32x2 o; o.x = pk2(dd[0], dd[1]); o.y = pk2(dd[2], dd[3]);
                *((u32x2*)(QB + (size_t)row * D) + c4) = o;
            }
            grid.sync();
            {
                const bf16_t* Wp = W_POOL + (size_t)layer * 4 * 65536;
                EpiResid E{HF, pool_scale + (size_t)layer * D, nullptr};
                pg8::Gemm g{QB, Wp, D, 256, 256, 256, 512};
                pg8::StaticOrder S; S.init(64, 4, G, bx);
                pg8::gemm_phase(lds, g, S, E);
                for (int piece = bx; piece < 160; piece += G) {
                    const int rg = piece >> 4, cgp = piece & 15, gi = cgp >> 2, row0 = MAINROWS + rg * 16, col0 = cgp * 64;
                    small_piece(lds, QB + (size_t)row0 * D + gi * 256, D, Wp + (size_t)gi * 65536 + (size_t)(col0 & 255) * 256, 256, 256, row0, col0, E);
                }
            }
            grid.sync();
        } else {
            const int bi = layer - 2;
            {
                const bf16_t* Wq = W_Q + (size_t)bi * 1024 * 1024;
                EpiQ E{QB, attn_bq + (size_t)bi * D};
                pg8::Gemm g{HB, Wq, D, D, D, 256, 0};
                pg8::StaticOrder S; S.init(64, 4, G, bx);
                pg8::gemm_phase(lds, g, S, E);
                for (int piece = bx; piece < 160; piece += G) {
                    const int rg = piece >> 4, cgp = piece & 15, row0 = MAINROWS + rg * 16, col0 = cgp * 64;
                    small_piece(lds, HB + (size_t)row0 * D, D, Wq + (size_t)col0 * D, D, D, row0, col0, E);
                }
            }
            grid.sync();
            {
                PHASE_IDS;
                const float* sinks = attn_sinks + bi * 16;
                for (int unit = bx; unit < 2 * 129 * 4; unit += G) {
                    const int kvh = unit & 3, bq = unit >> 2, b = bq / 129, qt = bq % 129, kbase = 64 * qt - 128;
                    for (int i = tid; i < 1536; i += 512) { const int row = i >> 3, ch = i & 7, kp = kbase + row;
                        u32x4 v = (u32x4){0u, 0u, 0u, 0u}; if (kp >= 0) v = *(const u32x4*)(KB + (size_t)(b * LP + kp) * 256 + kvh * 64 + ch * 8);
                        *(LAS u32x4*)(lds + row * 144 + ch * 16) = v; }
                    for (int i = tid; i < 1536; i += 512) { const int d = i / 24, ch = i % 24, kp = kbase + ch * 8;
                        u32x4 v = (u32x4){0u, 0u, 0u, 0u}; if (kp >= 0) v = *(const u32x4*)(VT + (size_t)(kvh * 64 + d) * KVROWS + b * LP + kp);
                        *(LAS u32x4*)(lds + 27648 + d * 400 + ch * 16) = v; }
                    __syncthreads();
                    {
                        const int hg = wave & 3, qb = wave >> 2, h = kvh * 4 + hg, q0 = 64 * qt + 32 * qb, ql = lane & 31, hi = lane >> 5;
                        const int qp = q0 + ql; const size_t qrow = (size_t)b * LP + qp;
                        bf16x8 qf[4];
#pragma unroll
                        for (int ds = 0; ds < 4; ++ds) qf[ds] = *(const bf16x8*)(QB + qrow * D + h * 64 + 16 * ds + 8 * hi);
                        f32x16 s[5];
#pragma unroll
                        for (int kbi = 0; kbi < 5; ++kbi) {
                            f32x16 acc;
#pragma unroll
                            for (int r = 0; r < 16; ++r) acc[r] = 0.f;
#pragma unroll
                            for (int ds = 0; ds < 4; ++ds) { const bf16x8 kf = *(const LAS bf16x8*)(lds + (32 * (qb + kbi) + ql) * 144 + (16 * ds + 8 * hi) * 2);
                                acc = __builtin_amdgcn_mfma_f32_32x32x16_bf16(kf, qf[ds], acc, 0, 0, 0); }
                            s[kbi] = acc;
                        }
                        const float sink = sinks[h];
                        float mx = -1e30f;
#pragma unroll
                        for (int kbi = 0; kbi < 5; ++kbi)
#pragma unroll
                            for (int r = 0; r < 16; ++r) { const int kp = kbase + 32 * (qb + kbi) + (r & 3) + 8 * (r >> 2) + 4 * hi;
                                const bool valid = (kp >= 0) && (kp <= qp) && (qp - kp < 128);
                                const float v = valid ? s[kbi][r] : -1e30f; s[kbi][r] = v; mx = fmaxf(mx, v); }
                        mx = fmaxf(mx, __shfl_xor(mx, 32)); mx = fmaxf(mx, sink);
                        float sum = 0.f;
#pragma unroll
                        for (int kbi = 0; kbi < 5; ++kbi)
#pragma unroll
                            for (int r = 0; r < 16; ++r) { const float e = __builtin_amdgcn_exp2f((s[kbi][r] - mx) * LOG2E); s[kbi][r] = e; sum += e; }
                        sum += __shfl_xor(sum, 32);
                        const float inv = 1.0f / (sum + __builtin_amdgcn_exp2f((sink - mx) * LOG2E));
                        f32x16 o[2];
#pragma unroll
                        for (int db = 0; db < 2; ++db)
#pragma unroll
                            for (int r = 0; r < 16; ++r) o[db][r] = 0.f;
#pragma unroll
                        for (int kbi = 0; kbi < 5; ++kbi)
#pragma unroll
                            for (int j = 0; j < 2; ++j) {
                                u32x4 pu;
#pragma unroll
                                for (int i = 0; i < 4; ++i) pu[i] = pk2(s[kbi][8 * j + 2 * i], s[kbi][8 * j + 2 * i + 1]);
                                const bf16x8 pbv = __builtin_bit_cast(bf16x8, pu);
#pragma unroll
                                for (int db = 0; db < 2; ++db) {
                                    const LAS unsigned char* base = lds + 27648 + (32 * db + ql) * 400 + (32 * (qb + kbi) + 16 * j + 4 * hi) * 2;
                                    const s16x4 lo = *(const LAS s16x4*)base, hh = *(const LAS s16x4*)(base + 16);
                                    const bf16x8 av = (bf16x8){lo[0], lo[1], lo[2], lo[3], hh[0], hh[1], hh[2], hh[3]};
                                    o[db] = __builtin_amdgcn_mfma_f32_32x32x16_bf16(av, pbv, o[db], 0, 0, 0);
                                }
                            }
                        if (qp < LP) {
#pragma unroll
                            for (int db = 0; db < 2; ++db)
#pragma unroll
                                for (int g4 = 0; g4 < 4; ++g4) { const int dd = 32 * db + 8 * g4 + 4 * hi;
                                    u32x2 w; w.x = pk2(o[db][4 * g4] * inv, o[db][4 * g4 + 1] * inv); w.y = pk2(o[db][4 * g4 + 2] * inv, o[db][4 * g4 + 3] * inv);
                                    *(u32x2*)(OB + qrow * D + h * 64 + dd) = w; }
                        }
                    }
                    __syncthreads();
                }
                for (int task = gw; task < 2048; task += NGW) {
                    const int s = task >> 4, h = task & 15, kvh = h >> 2; const size_t row = (size_t)NPR + s;
                    const float qv = bf2f(QB[row * D + h * 64 + lane]);
                    const int rb = (lane + 65) < 127 ? (lane + 65) : 127;
                    const f32x4* kA = (const f32x4*)(state_k + (((size_t)s * 128 + lane + 1) * 4 + kvh) * 64);
                    const f32x4* kBp = (const f32x4*)(state_k + (((size_t)s * 128 + rb) * 4 + kvh) * 64);
                    float sA = 0.f, sB = 0.f;
#pragma unroll
                    for (int d4 = 0; d4 < 16; ++d4) { const f32x4 ka = kA[d4], kb = kBp[d4];
                        const float q0 = rdlane(qv, 4 * d4), q1 = rdlane(qv, 4 * d4 + 1), q2 = rdlane(qv, 4 * d4 + 2), q3 = rdlane(qv, 4 * d4 + 3);
                        sA += ka[0] * q0 + ka[1] * q1 + ka[2] * q2 + ka[3] * q3; sB += kb[0] * q0 + kb[1] * q1 + kb[2] * q2 + kb[3] * q3; }
                    const float snew = wave_sum(bf2f(KB[row * 256 + kvh * 64 + lane]) * qv);
                    if (lane == 63) sB = snew;
                    const float sink = sinks[h];
                    const float mx = fmaxf(wave_max(fmaxf(sA, sB)), sink);
                    const float eA = __builtin_amdgcn_exp2f((sA - mx) * LOG2E), eB = __builtin_amdgcn_exp2f((sB - mx) * LOG2E);
                    const float den = wave_sum(eA + eB) + __builtin_amdgcn_exp2f((sink - mx) * LOG2E);
                    float acc = 0.f;
                    const float* vb = state_v + (((size_t)s * 128) * 4 + kvh) * 64 + lane;
#pragma unroll 16
                    for (int j = 0; j < 64; ++j) acc += rdlane(eA, j) * vb[(size_t)(j + 1) * 256];
#pragma unroll 9
                    for (int j = 0; j < 63; ++j) acc += rdlane(eB, j) * vb[(size_t)(j + 65) * 256];
                    acc += rdlane(eB, 63) * bf2f(VT[(size_t)(kvh * 64 + lane) * KVROWS + row]);
                    OB[row * D + h * 64 + lane] = (bf16_t)f2bf(acc / den);
                }
            }
            grid.sync();
            {
                const bf16_t* Wo = W_O + (size_t)bi * 1024 * 1024;
                EpiResid E{HF, nullptr, attn_bo + (size_t)bi * D};
                pg8::Gemm g{OB, Wo, D, D, D, 256, 0};
                pg8::StaticOrder S; S.init(64, 4, G, bx);
                pg8::gemm_phase(lds, g, S, E);
                for (int piece = bx; piece < 160; piece += G) {
                    const int rg = piece >> 4, cgp = piece & 15, row0 = MAINROWS + rg * 16, col0 = cgp * 64;
                    small_piece(lds, OB + (size_t)row0 * D, D, Wo + (size_t)col0 * D, D, D, row0, col0, E);
                }
            }
            grid.sync();
        }
        for (int pass = 0; pass < 2; ++pass) {
            if (pass == 1) {
                {
                    EpiFfnIn E{HMID, ffn_convw + (size_t)layer * 3 * FF, ffn_convb + (size_t)layer * FF, state_conv + (size_t)layer * 128 * 2 * FF,
                               out + O_CP + (size_t)layer * 2 * 2 * FF, out + O_CS + (size_t)layer * 128 * 2 * FF, (LAS float*)(lds + EXCH_OFF)};
                    pg8::Gemm g{HB - (size_t)2 * D, W_IN + (size_t)layer * 5632 * 1024, D, D, D, 254, 0};
                    pg8::StaticOrder S; S.init(66, 22, G, bx);
                    pg8::gemm_phase(lds, g, S, E);
                }
                grid.sync();
                {
                    const bf16_t* Wo = W_OUT + (size_t)layer * 1024 * 2816;
                    EpiResid E{HF, nullptr, nullptr};
                    pg8::Gemm g{HMID, Wo, FF, FF, FF, 256, 0};
                    pg8::StaticOrder S; S.init(64, 4, G, bx);
                    pg8::gemm_phase(lds, g, S, E);
                    for (int piece = bx; piece < 160; piece += G) {
                        const int rg = piece >> 4, cgp = piece & 15, row0 = MAINROWS + rg * 16, col0 = cgp * 64;
                        small_piece(lds, HMID + (size_t)row0 * FF, FF, Wo + (size_t)col0 * FF, FF, FF, row0, col0, E);
                    }
                }
                grid.sync();
            }
            PHASE_IDS;
            const float* gam = (pass == 0 ? ln_mix_g : ln_ffn_g) + (size_t)layer * D; const float* bet = (pass == 0 ? ln_mix_b : ln_ffn_b) + (size_t)layer * D;
            const bool fin = (layer == 3 && pass == 1);
            f32x4 gv[4], bv[4];
#pragma unroll
            for (int j = 0; j < 4; ++j) { gv[j] = *((const f32x4*)gam + lane + 64 * j); bv[j] = *((const f32x4*)bet + lane + 64 * j); }
            for (int row = gw; row < NROWS; row += NGW) {
                f32x4* xr = (f32x4*)(HF + (size_t)row * D) + lane;
                f32x4 v[4]; float sm = 0.f;
#pragma unroll
                for (int j = 0; j < 4; ++j) { v[j] = xr[64 * j]; sm += (v[j][0] + v[j][1]) + (v[j][2] + v[j][3]); }
                const float mean = wave_sum(sm) * (1.f / D); float s2 = 0.f;
#pragma unroll
                for (int j = 0; j < 4; ++j) { v[j] = v[j] - mean; s2 += (v[j][0] * v[j][0] + v[j][1] * v[j][1]) + (v[j][2] * v[j][2] + v[j][3] * v[j][3]); }
                const float rstd = 1.f / sqrtf(wave_sum(s2) * (1.f / D) + LN_EPS);
                float* yo = nullptr;
                if (fin) { if (row < NPR) { const int b = row >= LP ? 1 : 0, p = row - b * LP; if (p >= 16) yo = out + O_YP + ((size_t)b * 8192 + (p - 16)) * D; } else yo = out + O_YS + (size_t)(row - NPR) * D; }
#pragma unroll
                for (int j = 0; j < 4; ++j) {
                    const f32x4 y = v[j] * rstd * gv[j] + bv[j];
                    xr[64 * j] = y;
                    u32x2 o; o.x = pk2(y[0], y[1]); o.y = pk2(y[2], y[3]);
                    *((u32x2*)(HB + (size_t)row * D) + lane + 64 * j) = o;
                    if (yo) *((f32x4*)yo + lane + 64 * j) = y;
                }
            }
            grid.sync();
        }
        if (layer == 1) {
            {
                EpiK E{KB, b_kv, out};
                pg8::Gemm g{HB, W_KV, D, D, D, 256, 0};
                pg8::StaticOrder S; S.init(65, 1, G, bx);
                pg8::gemm_phase(lds, g, S, E);
            }
            {
                EpiVt E{VT, b_kv + 256, out};
                pg8::Gemm g{W_KV + (size_t)256 * D, HB, D, D, D, 256, 0};
                pg8::StaticOrder S; S.init(1, 65, G, (bx + G - 128 % G) % G);
                pg8::gemm_phase(lds, g, S, E);
            }
            grid.sync();
        }
    }
}

extern "C" void kernel_launch(void* const* d_in, const int* in_sizes, int n_in, void* d_out, int out_size, void* d_ws, size_t ws_size, hipStream_t stream) {
    static int grid_blocks = 0;
    if (grid_blocks == 0) {
        if (n_in != 24 || (size_t)out_size != O_END || ws_size < WS_END) { fprintf(stderr, "kernel_launch: unexpected shapes: n_in %d out %d ws %zu (need %zu)\n", n_in, out_size, ws_size, (size_t)WS_END); grid_blocks = -1; return; }
        int dev = 0, cus = 0, per_cu = 0;
        hipGetDevice(&dev);
        hipDeviceGetAttribute(&cus, hipDeviceAttributeMultiprocessorCount, dev);
        if (hipFuncSetAttribute((const void*)mega, hipFuncAttributeMaxDynamicSharedMemorySize, LDS_BYTES) != hipSuccess) { fprintf(stderr, "kernel_launch: hipFuncSetAttribute failed\n"); grid_blocks = -1; return; }
        if (hipOccupancyMaxActiveBlocksPerMultiprocessor(&per_cu, (const void*)mega, 512, LDS_BYTES) != hipSuccess || per_cu < 1) { fprintf(stderr, "kernel_launch: occupancy query says %d blocks/CU\n", per_cu); (void)hipGetLastError(); grid_blocks = -1; return; }
        grid_blocks = cus;
    }
    if (grid_blocks < 0) return;
    Args a{};
    for (int i = 0; i < 24; ++i) a.in[i] = (const float*)d_in[i];
    a.out = (float*)d_out; a.ws = (unsigned char*)d_ws;
    void* args[] = {&a};
    hipError_t e = hipLaunchCooperativeKernel((const void*)mega, dim3(grid_blocks), dim3(512), args, LDS_BYTES, stream);
    if (e != hipSuccess) fprintf(stderr, "cooperative launch failed: %s (grid %d)\n", hipGetErrorString(e), grid_blocks);
}
```

```cpp
#include <hip/hip_runtime.h>
#include <hip/hip_cooperative_groups.h>
#include <cstdio>
#include <cstdint>
namespace cg = cooperative_groups;

#define LAS __attribute__((address_space(3)))
typedef unsigned short bf16_t;
typedef short bf16x8 __attribute__((ext_vector_type(8)));
typedef short s16x4 __attribute__((ext_vector_type(4)));
typedef float f32x4 __attribute__((ext_vector_type(4)));
typedef float f32x16 __attribute__((ext_vector_type(16)));
typedef unsigned u32x4 __attribute__((ext_vector_type(4)));
typedef unsigned u32x2 __attribute__((ext_vector_type(2)));

constexpr int D = 1024, FF = 2816, LP = 8208  , NPR = 2 * LP  , NS = 128, NROWS = NPR + NS  ;
constexpr int RA = 16896;
constexpr int MAINROWS = 16384;
constexpr int KVROWS = 16640;
constexpr float ALPHA = 1.6817928305074290f;
constexpr float LN_EPS = 1e-5f;
constexpr float LOG2E = 1.4426950408889634f;

constexpr size_t O_YP = 0, O_YS = O_YP + (size_t)2 * 8192 * 1024, O_PP = O_YS + (size_t)128 * 1024, O_PS = O_PP + (size_t)2 * 2 * 15 * 1024,
                 O_CP = O_PS + (size_t)2 * 128 * 15 * 1024, O_CS = O_CP + (size_t)4 * 2 * 2 * FF, O_KP = O_CS + (size_t)4 * 128 * 2 * FF,
                 O_VP = O_KP + (size_t)2 * 128 * 256, O_KS = O_VP + (size_t)2 * 128 * 256, O_VS = O_KS + (size_t)128 * 128 * 256, O_END = O_VS + (size_t)128 * 128 * 256;

constexpr size_t MiB = 1u << 20;
constexpr size_t WS_WIN = 1 * MiB;
constexpr size_t WS_WOUT = WS_WIN + (size_t)4 * 5632 * 1024 * 2;
constexpr size_t WS_WQ = WS_WOUT + (size_t)4 * 1024 * 2816 * 2;
constexpr size_t WS_WO = WS_WQ + (size_t)2 * 1024 * 1024 * 2;
constexpr size_t WS_WKV = WS_WO + (size_t)2 * 1024 * 1024 * 2;
constexpr size_t WS_WPOOL = WS_WKV + (size_t)512 * 1024 * 2;
constexpr size_t WS_HF = WS_WPOOL + (size_t)8 * 256 * 256 * 2;
constexpr size_t WS_HB = WS_HF + (size_t)RA * 1024 * 4;
constexpr size_t WS_HMID = WS_HB + (size_t)(RA + 8) * 1024 * 2;
constexpr size_t WS_Q = WS_HMID;
constexpr size_t WS_O = WS_HMID + (size_t)RA * 1024 * 2;
constexpr size_t WS_KB = WS_HMID + (size_t)RA * FF * 2;
constexpr size_t WS_VT = WS_KB + (size_t)KVROWS * 256 * 2;
constexpr size_t WS_END = WS_VT + (size_t)KVROWS * 256 * 2;
static_assert(WS_O + (size_t)RA * 1024 * 2 <= WS_KB, "overlay");

constexpr int STAGE_LDS = 131072, EXCH_OFF = STAGE_LDS, MISC_OFF = EXCH_OFF + 4096, LDS_BYTES = 147456;
constexpr size_t CTL_BYTES = 16384;

__device__ __forceinline__ unsigned f2bf(float f) { unsigned u = __builtin_bit_cast(unsigned, f); return (u + 0x7fffu + ((u >> 16) & 1u)) >> 16; }
__device__ __forceinline__ unsigned pk2(float lo, float hi) { return f2bf(lo) | (f2bf(hi) << 16); }
__device__ __forceinline__ float bf2f(bf16_t v) { return __builtin_bit_cast(float, (unsigned)v << 16); }
__device__ __forceinline__ float wave_sum(float v) {
#pragma unroll
    for (int o = 1; o < 64; o <<= 1) v += __shfl_xor(v, o);
    return v;
}
__device__ __forceinline__ float wave_max(float v) {
#pragma unroll
    for (int o = 1; o < 64; o <<= 1) v = fmaxf(v, __shfl_xor(v, o));
    return v;
}
__device__ __forceinline__ float rdlane(float v, int l) { return __builtin_bit_cast(float, __builtin_amdgcn_readlane(__builtin_bit_cast(int, v), l)); }

__device__ __forceinline__ int launder_v(int x) { asm volatile("" : "+v"(x)); return x; }
__device__ __forceinline__ int launder_s(int x) { asm volatile("" : "+s"(x)); return x; }
namespace pg8 {
constexpr int BM = 256, BK = 64, HALF = 128, HTB = HALF * BK * 2, NXCD = 8, WGM = 8;
__device__ __forceinline__ int lds_byte(int r, int c) { const int st = (r >> 4) * 2 + (c >> 5), rr = r & 15, cc = c & 31, ob = rr * 64 + cc * 2; return st * 1024 + (ob ^ (((ob >> 9) & 1) << 5)); }
__device__ __forceinline__ void stage_rc(int b, int& R, int& C) { const int st = b / 1024, sb = b % 1024, swz = sb ^ (((sb >> 9) & 1) << 5); R = (st >> 1) * 16 + swz / 64; C = (st & 1) * 32 + (swz % 64) / 2; }
struct Unit { int pm, pn; };
struct Gemm { const bf16_t* A; const bf16_t* Bt; int lda, ldb, K, a_rows, a_pn_bytes; };
struct StaticOrder {
    int nM, nN, nwg, G, c;
    __device__ void init(int nM_, int nN_, int G_, int c_) { nM = nM_; nN = nN_; nwg = nM * nN; G = G_; c = c_; }
    __device__ bool next(int i, Unit& u) const {
        const long L = (long)i * G + c; if (L >= nwg) return false;
        int wgid = (int)L; { const int q = nwg / NXCD, r = nwg % NXCD, xcd = wgid % NXCD, off = wgid / NXCD; wgid = (xcd < r ? xcd * (q + 1) : r * (q + 1) + (xcd - r) * q) + off; }
        const int nig = WGM * nN, gid = wgid / nig, fm = gid * WGM, gsz = (nM - fm) < WGM ? (nM - fm) : WGM;
        u.pm = fm + ((wgid % nig) % gsz); u.pn = (wgid % nig) / gsz; return true;
    }
};

template <class Epi, class Sched>
__device__ __forceinline__ void gemm_phase(LAS unsigned char* lds, const Gemm g, const Sched& S, const Epi& E) {
    const int tid = launder_v(threadIdx.x), wid = __builtin_amdgcn_readfirstlane(tid >> 6), lane = tid & 63, wr = wid >> 2, wc = wid & 3, fr = lane & 15, fq = lane >> 4;
    const int K = g.K, nt = K / BK;
    unsigned voffA[2], voffB[2];
#pragma unroll
    for (int i = 0; i < 2; ++i) { int R, C; stage_rc(tid * 16 + i * 8192, R, C); voffA[i] = (unsigned)(R * g.lda + C) * 2u; voffB[i] = (unsigned)(R * g.ldb + C) * 2u; }
    const size_t kstep = (size_t)(BK * 2);
    const size_t hstepA = (size_t)HALF * g.lda * 2, hstepB = (size_t)HALF * g.ldb * 2;
    const size_t tstepA = (size_t)g.a_rows * g.lda * 2, tstepB = (size_t)BM * g.ldb * 2;
    const unsigned ldsw = (unsigned)wid * 1024u;
    const int aoff = lds_byte(wr * 64 + fr, fq * 8), boff = lds_byte(wc * 32 + fr, fq * 8);
#define PG8_SA(b, h) (((b) * 2 + (h)) * HTB)
#define PG8_SB(b, h) ((4 + (b) * 2 + (h)) * HTB)
#define PG8_STAGE(bufoff, gbase, voff) do { _Pragma("unroll") for (int _i = 0; _i < 2; ++_i) \
        __builtin_amdgcn_global_load_lds((const unsigned*)((const char*)(gbase) + (voff)[_i]), (LAS unsigned*)(lds + (bufoff) + ldsw + _i * 8192), 16, 0, 0); } while (0)
#define PG8_LDA(dst, b, h) do { _Pragma("unroll") for (int m = 0; m < 4; ++m) _Pragma("unroll") for (int k = 0; k < 2; ++k) dst[m][k] = *(const LAS bf16x8*)(lds + PG8_SA(b, h) + aoff + m * 2048 + k * 1024); } while (0)
#define PG8_LDB(dst, b, h) do { _Pragma("unroll") for (int n = 0; n < 2; ++n) _Pragma("unroll") for (int k = 0; k < 2; ++k) dst[n][k] = *(const LAS bf16x8*)(lds + PG8_SB(b, h) + boff + n * 2048 + k * 1024); } while (0)
#define PG8_MMA(ai, bj, At, Bt) do { __builtin_amdgcn_s_setprio(1); _Pragma("unroll") for (int m = 0; m < 4; ++m) _Pragma("unroll") for (int n = 0; n < 2; ++n) _Pragma("unroll") for (int k = 0; k < 2; ++k) \
        acc[ai][bj][m][n] = __builtin_amdgcn_mfma_f32_16x16x32_bf16(Bt[n][k], At[m][k], acc[ai][bj][m][n], 0, 0, 0); __builtin_amdgcn_s_setprio(0); } while (0)
#define PG8_WAIT_V(n) asm volatile("s_waitcnt vmcnt(" #n ")" ::: "memory")
#define PG8_WAIT_L(n) asm volatile("s_waitcnt lgkmcnt(" #n ")" ::: "memory")
#define PG8_BAR __builtin_amdgcn_s_barrier()
#define PG8_SCHED __builtin_amdgcn_sched_barrier(0)
    Unit cur, nxt; int ui = 0;
    if (!S.next(0, cur)) return;
    f32x4 acc[2][2][4][2];
#pragma unroll
    for (int a = 0; a < 2; ++a)
#pragma unroll
        for (int b = 0; b < 2; ++b)
#pragma unroll
            for (int m = 0; m < 4; ++m)
#pragma unroll
                for (int n = 0; n < 2; ++n) acc[a][b][m][n] = (f32x4){0.f, 0.f, 0.f, 0.f};
    bf16x8 At[4][2], B0[2][2], B1[2][2];
    const char* cA = (const char*)g.A + (size_t)cur.pm * tstepA + (size_t)cur.pn * g.a_pn_bytes; const char* cB = (const char*)g.Bt + (size_t)cur.pn * tstepB;
    PG8_STAGE(PG8_SB(0, 0), cB, voffB); PG8_STAGE(PG8_SB(0, 1), cB + hstepB, voffB); PG8_STAGE(PG8_SA(0, 0), cA, voffA); PG8_STAGE(PG8_SA(0, 1), cA + hstepA, voffA);
    if (wr == 1) PG8_BAR;
    PG8_WAIT_V(2); PG8_BAR;
    PG8_STAGE(PG8_SB(1, 0), cB + kstep, voffB); PG8_STAGE(PG8_SA(1, 0), cA + kstep, voffA); PG8_STAGE(PG8_SB(1, 1), cB + hstepB + kstep, voffB);
    PG8_WAIT_V(6); PG8_BAR;
    for (;;) {
        const bool has_next = S.next(ui + 1, nxt);
        const char* nA = has_next ? (const char*)g.A + (size_t)nxt.pm * tstepA + (size_t)nxt.pn * g.a_pn_bytes : cA; const char* nB = has_next ? (const char*)g.Bt + (size_t)nxt.pn * tstepB : cB;
        for (int t = 0; t < nt; t += 2) {
            const bool last = (t == nt - 2);
            const char* a1 = cA + (size_t)(t + 1) * kstep;
            const char* a2 = last ? nA : cA + (size_t)(t + 2) * kstep; const char* b2 = last ? nB : cB + (size_t)(t + 2) * kstep;
            const char* a3 = a2 + kstep; const char* b3 = b2 + kstep;
            PG8_LDB(B0, 0, 0); PG8_LDB(B1, 0, 1); PG8_SCHED; PG8_LDA(At, 0, 0); PG8_STAGE(PG8_SA(1, 1), a1 + hstepA, voffA);
            PG8_WAIT_V(8); PG8_WAIT_L(0); PG8_BAR; PG8_MMA(0, 0, At, B0); PG8_MMA(0, 1, At, B1); PG8_BAR; PG8_SCHED;
            PG8_LDA(At, 0, 1); PG8_STAGE(PG8_SB(0, 0), b2, voffB); PG8_STAGE(PG8_SB(0, 1), b2 + hstepB, voffB); PG8_STAGE(PG8_SA(0, 0), a2, voffA);
            PG8_WAIT_V(8); PG8_WAIT_L(0); PG8_BAR; PG8_MMA(1, 0, At, B0); PG8_MMA(1, 1, At, B1); PG8_BAR; PG8_SCHED;
            PG8_LDB(B0, 1, 0); PG8_LDB(B1, 1, 1); PG8_SCHED; PG8_LDA(At, 1, 0); PG8_STAGE(PG8_SA(0, 1), a2 + hstepA, voffA);
            PG8_WAIT_V(8); PG8_WAIT_L(0); PG8_BAR; PG8_MMA(0, 0, At, B0); PG8_MMA(0, 1, At, B1); PG8_BAR; PG8_SCHED;
            PG8_LDA(At, 1, 1); PG8_STAGE(PG8_SB(1, 0), b3, voffB); PG8_STAGE(PG8_SB(1, 1), b3 + hstepB, voffB); PG8_STAGE(PG8_SA(1, 0), a3, voffA);
            PG8_WAIT_V(8); PG8_WAIT_L(0); PG8_BAR; PG8_MMA(1, 0, At, B0); PG8_MMA(1, 1, At, B1); PG8_BAR; PG8_SCHED;
        }
        if (wr == 0) PG8_BAR;
        E(acc, cur, wr, wc, fr, fq);
        if (!has_next) break;
#pragma unroll
        for (int a = 0; a < 2; ++a)
#pragma unroll
            for (int b = 0; b < 2; ++b)
#pragma unroll
                for (int m = 0; m < 4; ++m)
#pragma unroll
                    for (int n = 0; n < 2; ++n) acc[a][b][m][n] = (f32x4){0.f, 0.f, 0.f, 0.f};
        cur = nxt; cA = nA; cB = nB; ++ui;
        if (wr == 1) PG8_BAR;
    }
    PG8_WAIT_V(0);
    PG8_BAR;
#undef PG8_SA
#undef PG8_SB
#undef PG8_STAGE
#undef PG8_LDA
#undef PG8_LDB
#undef PG8_MMA
#undef PG8_WAIT_V
#undef PG8_WAIT_L
#undef PG8_BAR
#undef PG8_SCHED
}
}


#define XB_TMO      128
#define XB_XCNT(j)  (256  + 64 * (j))
#define XB_XSUB(j)  (1280 + 64 * (j))
#define XB_XGEN(j)  (2304 + 64 * (j))
#define XB_TOP      3328
#define XB_TOPGEN   3392
#define XCD_BAR_WORDS 3456
#define XB_SPIN_CAP (1u << 18)
__device__ __forceinline__ unsigned xb_ld(unsigned* p)              { return __hip_atomic_load(p, __ATOMIC_RELAXED, __HIP_MEMORY_SCOPE_AGENT); }
__device__ __forceinline__ unsigned xb_add(unsigned* p, unsigned v) { return __hip_atomic_fetch_add(p, v, __ATOMIC_RELAXED, __HIP_MEMORY_SCOPE_AGENT); }
__device__ __forceinline__ unsigned xb_xcc_id() { return (unsigned)__builtin_amdgcn_s_getreg((3 << 11) | 20) & 0xFu; }
#define XB_SPIN(cond, bar) do { unsigned _sp = 0; while (cond) { __builtin_amdgcn_s_sleep(1); \
    if ((++_sp & 255u) == 0u) { if (xb_ld(&(bar)[XB_TMO])) break; if (_sp > XB_SPIN_CAP) { atomicAdd(&(bar)[XB_TMO], 1u); break; } } } } while (0)
struct XcdBarrier { unsigned* bar; unsigned x; volatile LAS unsigned* st; };
__device__ __forceinline__ XcdBarrier xcd_barrier_post(unsigned* bar, volatile LAS unsigned* st) {
    XcdBarrier b; b.bar = bar; b.x = xb_xcc_id(); b.st = st;
    if (threadIdx.x == 0) (void)xb_add(&bar[XB_XCNT(b.x)], 1u);
    return b;
}
__device__ __forceinline__ void xcd_barrier_complete(unsigned* bar, unsigned x, unsigned& nloc, unsigned& nx) {
    const unsigned G = gridDim.x * gridDim.y * gridDim.z;
    unsigned sum, cnt, mine, sp = 0u;
    for (;;) {
        sum = 0u; cnt = 0u; mine = 0u;
#pragma unroll
        for (unsigned j = 0; j < 16; ++j) { const unsigned c = xb_ld(&bar[XB_XCNT(j)]); sum += c; cnt += (c > 0u) ? 1u : 0u; mine = (j == x) ? c : mine; }
        if (sum == G) break;
        __builtin_amdgcn_s_sleep(1);
        if ((++sp & 255u) == 0u) { if (xb_ld(&bar[XB_TMO])) break; if (sp > XB_SPIN_CAP) { atomicAdd(&bar[XB_TMO], 1u); break; } }
    }
    nloc = mine > 0u ? mine : 1u; nx = cnt > 0u ? cnt : 1u;
}
__device__ __forceinline__ void xcd_barrier(const XcdBarrier& b) {
    asm volatile("s_waitcnt vmcnt(0)" ::: "memory");
    __syncthreads();
    if (threadIdx.x == 0) {
        unsigned* bar = b.bar;
        __builtin_amdgcn_s_waitcnt(0);
        unsigned nloc = b.st[0], nx = b.st[1];
        if (nloc == 0u) { xcd_barrier_complete(bar, b.x, nloc, nx); b.st[0] = nloc; b.st[1] = nx; }
        const unsigned old = xb_add(&bar[XB_XSUB(b.x)], 1u);
        const unsigned gen = old / nloc;
        if (old + 1u == (gen + 1u) * nloc) {
            __builtin_amdgcn_fence(__ATOMIC_RELEASE, "agent");
            asm volatile("s_waitcnt vmcnt(0)" ::: "memory");
            const unsigned og = xb_add(&bar[XB_TOP], 1u);
            const unsigned tg = og / nx;
            if (og + 1u == (tg + 1u) * nx) xb_add(&bar[XB_TOPGEN], 1u);
            else XB_SPIN(xb_ld(&bar[XB_TOPGEN]) == tg, bar);
            __builtin_amdgcn_fence(__ATOMIC_ACQUIRE, "agent");
            xb_add(&bar[XB_XGEN(b.x)], 1u);
            asm volatile("s_waitcnt vmcnt(0)" ::: "memory");
        } else {
            XB_SPIN(xb_ld(&bar[XB_XGEN(b.x)]) == gen, bar);
            __builtin_amdgcn_fence(__ATOMIC_ACQUIRE, "agent");
            asm volatile("s_waitcnt vmcnt(0)" ::: "memory");
        }
    }
    __syncthreads();
}

typedef f32x4 AccT[2][2][4][2];

struct EpiResid {
    float* hf; const float* colscale; const float* bias;
    __device__ __forceinline__ void operator()(const AccT& acc, const pg8::Unit& u, int wr, int wc, int fr_, int fq_) const {
        const int fr = launder_v(fr_), fq = launder_v(fq_);
#pragma unroll
        for (int bj = 0; bj < 2; ++bj)
#pragma unroll
            for (int n = 0; n < 2; ++n) {
                const int c = u.pn * 256 + bj * 128 + wc * 32 + n * 16 + fq * 4;
                const f32x4 cs = colscale ? *(const f32x4*)(colscale + c) : (f32x4){1.f, 1.f, 1.f, 1.f};
                const f32x4 bv = bias ? *(const f32x4*)(bias + c) : (f32x4){0.f, 0.f, 0.f, 0.f};
#pragma unroll
                for (int ai = 0; ai < 2; ++ai)
#pragma unroll
                    for (int m = 0; m < 4; ++m) {
                        const int r = u.pm * 256 + ai * 128 + wr * 64 + m * 16 + fr;
                        f32x4* p = (f32x4*)(hf + (size_t)r * D + c);
                        *p = *p * ALPHA + (acc[ai][bj][m][n] * cs + bv);
                    }
            }
    }
    __device__ __forceinline__ void elem(int r, int c, float v) const {
        const float cs = colscale ? colscale[c] : 1.f, bv = bias ? bias[c] : 0.f;
        float* p = hf + (size_t)r * D + c; *p = *p * ALPHA + (v * cs + bv);
    }
};
struct EpiQ {
    bf16_t* Q; const float* bq;
    __device__ __forceinline__ void operator()(const AccT& acc, const pg8::Unit& u, int wr, int wc, int fr_, int fq_) const {
        const int fr = launder_v(fr_), fq = launder_v(fq_);
#pragma unroll
        for (int bj = 0; bj < 2; ++bj)
#pragma unroll
            for (int n = 0; n < 2; ++n) {
                const int c = u.pn * 256 + bj * 128 + wc * 32 + n * 16 + fq * 4;
                const f32x4 bv = *(const f32x4*)(bq + c);
#pragma unroll
                for (int ai = 0; ai < 2; ++ai)
#pragma unroll
                    for (int m = 0; m < 4; ++m) {
                        const int r = u.pm * 256 + ai * 128 + wr * 64 + m * 16 + fr;
                        const f32x4 v = (acc[ai][bj][m][n] + bv) * 0.125f;
                        u32x2 w; w.x = pk2(v[0], v[1]); w.y = pk2(v[2], v[3]);
                        *(u32x2*)(Q + (size_t)r * D + c) = w;
                    }
            }
    }
    __device__ __forceinline__ void elem(int r, int c, float v) const { Q[(size_t)r * D + c] = (bf16_t)f2bf((v + bq[c]) * 0.125f); }
};
struct EpiK {
    bf16_t* KB; const float* bk; float* out;
    __device__ __forceinline__ void operator()(const AccT& acc, const pg8::Unit& u, int wr, int wc, int fr_, int fq_) const {
        const int fr = launder_v(fr_), fq = launder_v(fq_);
#pragma unroll
        for (int bj = 0; bj < 2; ++bj)
#pragma unroll
            for (int n = 0; n < 2; ++n) {
                const int c = bj * 128 + wc * 32 + n * 16 + fq * 4;
                const f32x4 bv = *(const f32x4*)(bk + c);
#pragma unroll
                for (int ai = 0; ai < 2; ++ai)
#pragma unroll
                    for (int m = 0; m < 4; ++m) {
                        const int r = u.pm * 256 + ai * 128 + wr * 64 + m * 16 + fr;
                        const f32x4 v = acc[ai][bj][m][n] + bv;
                        u32x2 w; w.x = pk2(v[0], v[1]); w.y = pk2(v[2], v[3]);
                        *(u32x2*)(KB + (size_t)r * 256 + c) = w;
                        if (r < NPR) { const int b = r >= LP ? 1 : 0, p = r - b * LP; if (p >= LP - 128) *(f32x4*)(out + O_KP + ((size_t)(b * 128 + p - (LP - 128))) * 256 + c) = v; }
                        else if (r < NROWS) { *(f32x4*)(out + O_KS + ((size_t)(r - NPR) * 128 + 127) * 256 + c) = v; }
                    }
            }
    }
};
struct EpiVt {
    bf16_t* VT; const float* bv; float* out;
    __device__ __forceinline__ void operator()(const AccT& acc, const pg8::Unit& u, int wr, int wc, int fr_, int fq_) const {
        const int fr = launder_v(fr_), fq = launder_v(fq_);
#pragma unroll
        for (int ai = 0; ai < 2; ++ai)
#pragma unroll
            for (int m = 0; m < 4; ++m) {
                const int d = ai * 128 + wr * 64 + m * 16 + fr;
                const float b = bv[d];
#pragma unroll
                for (int bj = 0; bj < 2; ++bj)
#pragma unroll
                    for (int n = 0; n < 2; ++n) {
                        const int c = u.pn * 256 + bj * 128 + wc * 32 + n * 16 + fq * 4;
                        const f32x4 v = acc[ai][bj][m][n] + b;
                        u32x2 w; w.x = pk2(v[0], v[1]); w.y = pk2(v[2], v[3]);
                        *(u32x2*)(VT + (size_t)d * KVROWS + c) = w;
#pragma unroll
                        for (int j = 0; j < 4; ++j) { const int r = c + j;
                            if (r < NPR) { const int bb = r >= LP ? 1 : 0, p = r - bb * LP; if (p >= LP - 128) out[O_VP + ((size_t)(bb * 128 + p - (LP - 128))) * 256 + d] = v[j]; }
                            else if (r < NROWS) out[O_VS + ((size_t)(r - NPR) * 128 + 127) * 256 + d] = v[j]; }
                    }
            }
    }
};
struct EpiFfnIn {
    bf16_t* hmid; const float* convw; const float* convb; const float* state_conv; float* out_cp; float* out_cs; LAS float* exch;
    __device__ __forceinline__ void operator()(const AccT& acc, const pg8::Unit& u, int wr, int wc, int fr_, int fq_) const {
        const int fr = launder_v(fr_), fq = launder_v(fq_);
        const int lane = fq * 16 + fr;
        if (fr >= 14) {
#pragma unroll
            for (int ai = 0; ai < 2; ++ai)
#pragma unroll
                for (int n = 0; n < 2; ++n) *(LAS f32x4*)(exch + ((ai * 2 + wr) * 2 + (fr - 14)) * 128 + wc * 32 + n * 16 + fq * 4) = acc[ai][0][3][n];
        }
        asm volatile("s_waitcnt lgkmcnt(0)" ::: "memory"); __builtin_amdgcn_s_barrier(); asm volatile("" ::: "memory");
        const int src1 = (lane & 48) | ((fr + 15) & 15), src2 = (lane & 48) | ((fr + 14) & 15);
#pragma unroll
        for (int n = 0; n < 2; ++n) {
            const int ff = u.pn * 128 + wc * 32 + n * 16 + fq * 4;
            const f32x4 w0 = *(const f32x4*)(convw + ff), w1 = *(const f32x4*)(convw + FF + ff), w2 = *(const f32x4*)(convw + 2 * FF + ff), cb = *(const f32x4*)(convb + ff);
#pragma unroll
            for (int ai = 0; ai < 2; ++ai) {
                const int pbi = ai * 2 + wr - 1;
                f32x4 e14 = (f32x4){0.f, 0.f, 0.f, 0.f}, e15 = e14;
                if (pbi >= 0) { e14 = *(const LAS f32x4*)(exch + (pbi * 2 + 0) * 128 + wc * 32 + n * 16 + fq * 4); e15 = *(const LAS f32x4*)(exch + (pbi * 2 + 1) * 128 + wc * 32 + n * 16 + fq * 4); }
#pragma unroll
                for (int m = 0; m < 4; ++m) {
                    const int r_loc = ai * 128 + wr * 64 + m * 16 + fr; const int R = u.pm * 254 - 2 + r_loc;
                    const f32x4 g0 = acc[ai][0][m][n], uu = acc[ai][1][m][n];
                    f32x4 x1, x2;
                    if (m == 0) { x1 = g0; x2 = g0; } else { const f32x4 gp = acc[ai][0][m == 0 ? 0 : m - 1][n]; x1 = (fr == 15) ? gp : g0; x2 = (fr >= 14) ? gp : g0; }
                    f32x4 p1, p2;
#pragma unroll
                    for (int j = 0; j < 4; ++j) { p1[j] = __shfl(x1[j], src1); p2[j] = __shfl(x2[j], src2); }
                    if (m == 0) { if (fr == 0) { p1 = e15; p2 = e14; } else if (fr == 1) { p2 = e15; } }
                    const bool valid = (r_loc >= 2) && (R < NROWS);
                    if (valid) {
                        if (R < NPR) {
                            const int b = R >= LP ? 1 : 0, p = R - b * LP;
                            if (p < 1) p1 = (f32x4){0.f, 0.f, 0.f, 0.f};
                            if (p < 2) p2 = (f32x4){0.f, 0.f, 0.f, 0.f};
                            if (p >= LP - 2) *(f32x4*)(out_cp + ((size_t)(b * 2 + (p - (LP - 2)))) * FF + ff) = g0;
                        } else {
                            const int s = R - NPR;
                            p2 = *(const f32x4*)(state_conv + ((size_t)s * 2 + 0) * FF + ff);
                            p1 = *(const f32x4*)(state_conv + ((size_t)s * 2 + 1) * FF + ff);
                            *(f32x4*)(out_cs + ((size_t)s * 2 + 0) * FF + ff) = p1;
                            *(f32x4*)(out_cs + ((size_t)s * 2 + 1) * FF + ff) = g0;
                        }
                        const f32x4 c = cb + w0 * p2 + w1 * p1 + w2 * g0;
                        f32x4 h;
#pragma unroll
                        for (int j = 0; j < 4; ++j) h[j] = c[j] * __builtin_amdgcn_rcpf(1.f + __builtin_amdgcn_exp2f(-c[j] * LOG2E)) * uu[j];
                        u32x2 w; w.x = pk2(h[0], h[1]); w.y = pk2(h[2], h[3]);
                        *(u32x2*)(hmid + (size_t)R * FF + ff) = w;
                    }
                }
            }
        }
    }
};

template <class Epi>
__device__ __forceinline__ void small_piece(LAS unsigned char* lds, const bf16_t* A, int lda, const bf16_t* Bt, int ldb, int K, int row0, int col0, const Epi& E) {
    const int tid = launder_v(threadIdx.x), wid = __builtin_amdgcn_readfirstlane(tid >> 6), lane = tid & 63, fr = lane & 15, fq = lane >> 4;
    const int kw = K / 8, k0 = wid * kw;
    f32x4 acc[4];
#pragma unroll
    for (int n = 0; n < 4; ++n) acc[n] = (f32x4){0.f, 0.f, 0.f, 0.f};
    for (int ks = 0; ks < kw; ks += 32) {
        const bf16x8 a = *(const bf16x8*)(A + (size_t)fr * lda + k0 + ks + fq * 8);
#pragma unroll
        for (int n = 0; n < 4; ++n) {
            const bf16x8 b = *(const bf16x8*)(Bt + (size_t)(n * 16 + fr) * ldb + k0 + ks + fq * 8);
            acc[n] = __builtin_amdgcn_mfma_f32_16x16x32_bf16(b, a, acc[n], 0, 0, 0);
        }
    }
    LAS float* red = (LAS float*)lds;
#pragma unroll
    for (int n = 0; n < 4; ++n) *(LAS f32x4*)(red + wid * 1024 + fr * 64 + n * 16 + fq * 4) = acc[n];
    __syncthreads();
#pragma unroll
    for (int i = 0; i < 2; ++i) {
        const int idx = tid + i * 512; float s = 0.f;
#pragma unroll
        for (int w = 0; w < 8; ++w) s += red[w * 1024 + idx];
        E.elem(row0 + (idx >> 6), col0 + (idx & 63), s);
    }
    __syncthreads();
}

struct Args { const float* in[24]; float* out; unsigned char* ws; };

__device__ __forceinline__ void transpose_item(const float* W, int K, int N, bf16_t* WT, int k0, int n0, int drow0, LAS float* scr, int lane) {
#pragma unroll 8
    for (int i = 0; i < 32; ++i) { const int kk = 2 * i + (lane >> 5); scr[kk * 33 + (lane & 31)] = W[(size_t)(k0 + kk) * N + n0 + (lane & 31)]; }
    asm volatile("s_waitcnt lgkmcnt(0)" ::: "memory");
    const int c = lane & 7;
#pragma unroll
    for (int j = 0; j < 4; ++j) { const int n = (lane >> 3) + 8 * j; const LAS float* s = scr + (8 * c) * 33 + n;
        u32x4 o; o.x = pk2(s[0 * 33], s[1 * 33]); o.y = pk2(s[2 * 33], s[3 * 33]); o.z = pk2(s[4 * 33], s[5 * 33]); o.w = pk2(s[6 * 33], s[7 * 33]);
        *(u32x4*)(WT + (size_t)(drow0 + n) * K + k0 + 8 * c) = o; }
    asm volatile("s_waitcnt lgkmcnt(0)" ::: "memory");
}
__device__ __forceinline__ void transpose_matrix_item(const float* W, int K, int N, bf16_t* WT, int item, LAS float* scr, int lane, bool ffn_in) {
    const int nblk = N / 32, kb = item / nblk, nb = item % nblk, n0 = 32 * nb;
    int drow0 = n0;
    if (ffn_in) { const int isu = n0 >= FF ? 1 : 0, ff = n0 - isu * FF; drow0 = (ff >> 7) * 256 + isu * 128 + (ff & 127); }
    transpose_item(W, K, N, WT, 64 * kb, n0, drow0, scr, lane);
}

__global__ void __launch_bounds__(512, 2) mega(Args a) {
    extern __shared__ __attribute__((aligned(16))) unsigned char lds_raw[];
    LAS unsigned char* lds = (LAS unsigned char*)lds_raw;
    cg::grid_group grid = cg::this_grid();
    const int G = gridDim.x, bx = blockIdx.x, NGW = G * 8, NGT = G * 512;
#define PHASE_IDS const int tid = launder_v(threadIdx.x), lane = tid & 63, wave = __builtin_amdgcn_readfirstlane(tid >> 6), gw = bx * 8 + wave, gt = bx * 512 + tid; (void)lane; (void)gw; (void)gt; (void)wave
    unsigned char* ws = a.ws; float* out = a.out;
    if (threadIdx.x < 2) ((volatile LAS unsigned*)(lds + MISC_OFF))[threadIdx.x] = 0u;
    __syncthreads();
    const XcdBarrier xbar = xcd_barrier_post((unsigned*)ws, (volatile LAS unsigned*)(lds + MISC_OFF));
    const float* x_prompt = a.in[0]; const float* x_sample = a.in[1]; const float* state_pool = a.in[2]; const float* state_conv = a.in[3];
    const float* state_k = a.in[4]; const float* state_v = a.in[5]; const float* meta = a.in[6]; const float* pool_w = a.in[7]; const float* pool_scale = a.in[8];
    const float* w_kv = a.in[9]; const float* b_kv = a.in[10]; const float* attn_wq = a.in[11]; const float* attn_bq = a.in[12]; const float* attn_sinks = a.in[13];
    const float* attn_wo = a.in[14]; const float* attn_bo = a.in[15]; const float* ffn_win = a.in[16]; const float* ffn_convw = a.in[17]; const float* ffn_convb = a.in[18];
    const float* ffn_wout = a.in[19]; const float* ln_mix_g = a.in[20]; const float* ln_mix_b = a.in[21]; const float* ln_ffn_g = a.in[22]; const float* ln_ffn_b = a.in[23];
    bf16_t* W_IN = (bf16_t*)(ws + WS_WIN); bf16_t* W_OUT = (bf16_t*)(ws + WS_WOUT); bf16_t* W_Q = (bf16_t*)(ws + WS_WQ); bf16_t* W_O = (bf16_t*)(ws + WS_WO);
    bf16_t* W_KV = (bf16_t*)(ws + WS_WKV); bf16_t* W_POOL = (bf16_t*)(ws + WS_WPOOL);
    float* HF = (float*)(ws + WS_HF); bf16_t* HB = (bf16_t*)(ws + WS_HB) + (size_t)8 * D; bf16_t* HMID = (bf16_t*)(ws + WS_HMID);
    bf16_t* QB = (bf16_t*)(ws + WS_Q); bf16_t* OB = (bf16_t*)(ws + WS_O); bf16_t* KB = (bf16_t*)(ws + WS_KB); bf16_t* VT = (bf16_t*)(ws + WS_VT);

    {
        PHASE_IDS;
        LAS float* scr = (LAS float*)(lds + wave * 16384);
        constexpr int I_IN = (1024 / 64) * (5632 / 32), I_OUT = (2816 / 64) * (1024 / 32), I_SQ = 16 * 32, I_KV = 16 * 16, I_PL = 4 * 8;
        constexpr int NITEMS = 4 * I_IN + 4 * I_OUT + 4 * I_SQ + I_KV + 8 * I_PL;
        for (int it = gw; it < NITEMS; it += NGW) {
            int r = it;
            if (r < 4 * I_IN) { const int l = r / I_IN; transpose_matrix_item(ffn_win + (size_t)l * 1024 * 5632, 1024, 5632, W_IN + (size_t)l * 5632 * 1024, r % I_IN, scr, lane, true); continue; } r -= 4 * I_IN;
            if (r < 4 * I_OUT) { const int l = r / I_OUT; transpose_matrix_item(ffn_wout + (size_t)l * 2816 * 1024, 2816, 1024, W_OUT + (size_t)l * 1024 * 2816, r % I_OUT, scr, lane, false); continue; } r -= 4 * I_OUT;
            if (r < 2 * I_SQ) { const int l = r / I_SQ; transpose_matrix_item(attn_wq + (size_t)l * 1024 * 1024, 1024, 1024, W_Q + (size_t)l * 1024 * 1024, r % I_SQ, scr, lane, false); continue; } r -= 2 * I_SQ;
            if (r < 2 * I_SQ) { const int l = r / I_SQ; transpose_matrix_item(attn_wo + (size_t)l * 1024 * 1024, 1024, 1024, W_O + (size_t)l * 1024 * 1024, r % I_SQ, scr, lane, false); continue; } r -= 2 * I_SQ;
            if (r < I_KV) { transpose_matrix_item(w_kv, 1024, 512, W_KV, r, scr, lane, false); continue; } r -= I_KV;
            { const int l = r / I_PL; transpose_matrix_item(pool_w + (size_t)l * 65536, 256, 256, W_POOL + (size_t)l * 65536, r % I_PL, scr, lane, false); }
        }
        for (int row = gw; row < NROWS; row += NGW) {
            const float* src;
            if (row < NPR) { const int b = row >= LP ? 1 : 0, p = row - b * LP; src = p < 16 ? meta + (size_t)p * D : x_prompt + ((size_t)b * 8192 + (p - 16)) * D; }
            else src = x_sample + (size_t)(row - NPR) * D;
#pragma unroll
            for (int j = 0; j < 4; ++j) *((f32x4*)(HF + (size_t)row * D) + lane + 64 * j) = *((const f32x4*)src + lane + 64 * j);
        }
        for (int i = gt; i < 128 * 127 * 64; i += NGT) {
            const int c4 = i & 63, rr = (i >> 6) % 127, s = (i >> 6) / 127;
            *((f32x4*)(out + O_KS + ((size_t)s * 128 + rr) * 256) + c4) = *((const f32x4*)(state_k + ((size_t)s * 128 + rr + 1) * 256) + c4);
            *((f32x4*)(out + O_VS + ((size_t)s * 128 + rr) * 256) + c4) = *((const f32x4*)(state_v + ((size_t)s * 128 + rr + 1) * 256) + c4);
        }
    }
    grid.sync();

#pragma nounroll
    for (int layer_ = 0; layer_ < 4; ++layer_) {
        const int layer = launder_s(layer_);
        if (layer < 2) {
            PHASE_IDS;
            const float* sp = state_pool + (size_t)layer * 128 * 15 * D;
            for (int i = gt; i < NROWS * 256; i += NGT) {
                const int row = i >> 8, c4 = i & 255, gi = c4 >> 6, w = 2 << gi;
                const f32x4 x = *((const f32x4*)(HF + (size_t)row * D) + c4);
                f32x4 sum = x; int cnt;
                if (row < NPR) {
                    const int b = row >= LP ? 1 : 0, p = row - b * LP; cnt = (p + 1) < w ? (p + 1) : w;
                    for (int k = 1; k < cnt; ++k) sum += *((const f32x4*)(HF + (size_t)(row - k) * D) + c4);
                    if (p >= LP - 15) *((f32x4*)(out + O_PP + (((size_t)layer * 2 + b) * 15 + (p - (LP - 15))) * D) + c4) = x;
                } else {
                    const int s = row - NPR; cnt = w;
                    for (int k = 1; k < w; ++k) sum += *((const f32x4*)(sp + ((size_t)s * 15 + (15 - k)) * D) + c4);
                    float* op = out + O_PS + (((size_t)layer * 128 + s) * 15) * D;
                    *((f32x4*)(op + (size_t)14 * D) + c4) = x;
                    for (int k = 0; k < 14; ++k) *((f32x4*)(op + (size_t)k * D) + c4) = *((const f32x4*)(sp + ((size_t)s * 15 + k + 1) * D) + c4);
                }
                const f32x4 dd = sum * (1.0f / (float)cnt) - x;
                u32x2 o; o.x = pk2(dd[0], dd[1]); o.y = pk2(dd[2], dd[3]);
                *((u32x2*)(QB + (size_t)row * D) + c4) = o;
            }
            xcd_barrier(xbar);
            {
                const bf16_t* Wp = W_POOL + (size_t)layer * 4 * 65536;
                EpiResid E{HF, pool_scale + (size_t)layer * D, nullptr};
                pg8::Gemm g{QB, Wp, D, 256, 256, 256, 512};
                pg8::StaticOrder S; S.init(64, 4, G, bx);
                pg8::gemm_phase(lds, g, S, E);
                for (int piece = bx; piece < 160; piece += G) {
                    const int rg = piece >> 4, cgp = piece & 15, gi = cgp >> 2, row0 = MAINROWS + rg * 16, col0 = cgp * 64;
                    small_piece(lds, QB + (size_t)row0 * D + gi * 256, D, Wp + (size_t)gi * 65536 + (size_t)(col0 & 255) * 256, 256, 256, row0, col0, E);
                }
            }
            xcd_barrier(xbar);
        } else {
            const int bi = layer - 2;
            {
                const bf16_t* Wq = W_Q + (size_t)bi * 1024 * 1024;
                EpiQ E{QB, attn_bq + (size_t)bi * D};
                pg8::Gemm g{HB, Wq, D, D, D, 256, 0};
                pg8::StaticOrder S; S.init(64, 4, G, bx);
                pg8::gemm_phase(lds, g, S, E);
                for (int piece = bx; piece < 160; piece += G) {
                    const int rg = piece >> 4, cgp = piece & 15, row0 = MAINROWS + rg * 16, col0 = cgp * 64;
                    small_piece(lds, HB + (size_t)row0 * D, D, Wq + (size_t)col0 * D, D, D, row0, col0, E);
                }
            }
            xcd_barrier(xbar);
            {
                PHASE_IDS;
                const float* sinks = attn_sinks + bi * 16;
                for (int unit = bx; unit < 2 * 129 * 4; unit += G) {
                    const int kvh = unit & 3, bq = unit >> 2, b = bq / 129, qt = bq % 129, kbase = 64 * qt - 128;
                    for (int i = tid; i < 1536; i += 512) { const int row = i >> 3, ch = i & 7, kp = kbase + row;
                        u32x4 v = (u32x4){0u, 0u, 0u, 0u}; if (kp >= 0) v = *(const u32x4*)(KB + (size_t)(b * LP + kp) * 256 + kvh * 64 + ch * 8);
                        *(LAS u32x4*)(lds + row * 144 + ch * 16) = v; }
                    for (int i = tid; i < 1536; i += 512) { const int d = i / 24, ch = i % 24, kp = kbase + ch * 8;
                        u32x4 v = (u32x4){0u, 0u, 0u, 0u}; if (kp >= 0) v = *(const u32x4*)(VT + (size_t)(kvh * 64 + d) * KVROWS + b * LP + kp);
                        *(LAS u32x4*)(lds + 27648 + d * 400 + ch * 16) = v; }
                    __syncthreads();
                    {
                        const int hg = wave & 3, qb = wave >> 2, h = kvh * 4 + hg, q0 = 64 * qt + 32 * qb, ql = lane & 31, hi = lane >> 5;
                        const int qp = q0 + ql; const size_t qrow = (size_t)b * LP + qp;
                        bf16x8 qf[4];
#pragma unroll
                        for (int ds = 0; ds < 4; ++ds) qf[ds] = *(const bf16x8*)(QB + qrow * D + h * 64 + 16 * ds + 8 * hi);
                        f32x16 s[5];
#pragma unroll
                        for (int kbi = 0; kbi < 5; ++kbi) {
                            f32x16 acc;
#pragma unroll
                            for (int r = 0; r < 16; ++r) acc[r] = 0.f;
#pragma unroll
                            for (int ds = 0; ds < 4; ++ds) { const bf16x8 kf = *(const LAS bf16x8*)(lds + (32 * (qb + kbi) + ql) * 144 + (16 * ds + 8 * hi) * 2);
                                acc = __builtin_amdgcn_mfma_f32_32x32x16_bf16(kf, qf[ds], acc, 0, 0, 0); }
                            s[kbi] = acc;
                        }
                        const float sink = sinks[h];
                        float mx = -1e30f;
#pragma unroll
                        for (int kbi = 0; kbi < 5; ++kbi)
#pragma unroll
                            for (int r = 0; r < 16; ++r) { const int kp = kbase + 32 * (qb + kbi) + (r & 3) + 8 * (r >> 2) + 4 * hi;
                                const bool valid = (kp >= 0) && (kp <= qp) && (qp - kp < 128);
                                const float v = valid ? s[kbi][r] : -1e30f; s[kbi][r] = v; mx = fmaxf(mx, v); }
                        mx = fmaxf(mx, __shfl_xor(mx, 32)); mx = fmaxf(mx, sink);
                        float sum = 0.f;
#pragma unroll
                        for (int kbi = 0; kbi < 5; ++kbi)
#pragma unroll
                            for (int r = 0; r < 16; ++r) { const float e = __builtin_amdgcn_exp2f((s[kbi][r] - mx) * LOG2E); s[kbi][r] = e; sum += e; }
                        sum += __shfl_xor(sum, 32);
                        const float inv = 1.0f / (sum + __builtin_amdgcn_exp2f((sink - mx) * LOG2E));
                        f32x16 o[2];
#pragma unroll
                        for (int db = 0; db < 2; ++db)
#pragma unroll
                            for (int r = 0; r < 16; ++r) o[db][r] = 0.f;
#pragma unroll
                        for (int kbi = 0; kbi < 5; ++kbi)
#pragma unroll
                            for (int j = 0; j < 2; ++j) {
                                u32x4 pu;
#pragma unroll
                                for (int i = 0; i < 4; ++i) pu[i] = pk2(s[kbi][8 * j + 2 * i], s[kbi][8 * j + 2 * i + 1]);
                                const bf16x8 pbv = __builtin_bit_cast(bf16x8, pu);
#pragma unroll
                                for (int db = 0; db < 2; ++db) {
                                    const LAS unsigned char* base = lds + 27648 + (32 * db + ql) * 400 + (32 * (qb + kbi) + 16 * j + 4 * hi) * 2;
                                    const s16x4 lo = *(const LAS s16x4*)base, hh = *(const LAS s16x4*)(base + 16);
                                    const bf16x8 av = (bf16x8){lo[0], lo[1], lo[2], lo[3], hh[0], hh[1], hh[2], hh[3]};
                                    o[db] = __builtin_amdgcn_mfma_f32_32x32x16_bf16(av, pbv, o[db], 0, 0, 0);
                                }
                            }
                        if (qp < LP) {
#pragma unroll
                            for (int db = 0; db < 2; ++db)
#pragma unroll
                                for (int g4 = 0; g4 < 4; ++g4) { const int dd = 32 * db + 8 * g4 + 4 * hi;
                                    u32x2 w; w.x = pk2(o[db][4 * g4] * inv, o[db][4 * g4 + 1] * inv); w.y = pk2(o[db][4 * g4 + 2] * inv, o[db][4 * g4 + 3] * inv);
                                    *(u32x2*)(OB + qrow * D + h * 64 + dd) = w; }
                        }
                    }
                    __syncthreads();
                }
                for (int task = gw; task < 2048; task += NGW) {
                    const int s = task >> 4, h = task & 15, kvh = h >> 2; const size_t row = (size_t)NPR + s;
                    const float qv = bf2f(QB[row * D + h * 64 + lane]);
                    const int rb = (lane + 65) < 127 ? (lane + 65) : 127;
                    const f32x4* kA = (const f32x4*)(state_k + (((size_t)s * 128 + lane + 1) * 4 + kvh) * 64);
                    const f32x4* kBp = (const f32x4*)(state_k + (((size_t)s * 128 + rb) * 4 + kvh) * 64);
                    float sA = 0.f, sB = 0.f;
#pragma unroll
                    for (int d4 = 0; d4 < 16; ++d4) { const f32x4 ka = kA[d4], kb = kBp[d4];
                        const float q0 = rdlane(qv, 4 * d4), q1 = rdlane(qv, 4 * d4 + 1), q2 = rdlane(qv, 4 * d4 + 2), q3 = rdlane(qv, 4 * d4 + 3);
                        sA += ka[0] * q0 + ka[1] * q1 + ka[2] * q2 + ka[3] * q3; sB += kb[0] * q0 + kb[1] * q1 + kb[2] * q2 + kb[3] * q3; }
                    const float snew = wave_sum(bf2f(KB[row * 256 + kvh * 64 + lane]) * qv);
                    if (lane == 63) sB = snew;
                    const float sink = sinks[h];
                    const float mx = fmaxf(wave_max(fmaxf(sA, sB)), sink);
                    const float eA = __builtin_amdgcn_exp2f((sA - mx) * LOG2E), eB = __builtin_amdgcn_exp2f((sB - mx) * LOG2E);
                    const float den = wave_sum(eA + eB) + __builtin_amdgcn_exp2f((sink - mx) * LOG2E);
                    float acc = 0.f;
                    const float* vb = state_v + (((size_t)s * 128) * 4 + kvh) * 64 + lane;
#pragma unroll 16
                    for (int j = 0; j < 64; ++j) acc += rdlane(eA, j) * vb[(size_t)(j + 1) * 256];
#pragma unroll 9
                    for (int j = 0; j < 63; ++j) acc += rdlane(eB, j) * vb[(size_t)(j + 65) * 256];
                    acc += rdlane(eB, 63) * bf2f(VT[(size_t)(kvh * 64 + lane) * KVROWS + row]);
                    OB[row * D + h * 64 + lane] = (bf16_t)f2bf(acc / den);
                }
            }
            xcd_barrier(xbar);
            {
                const bf16_t* Wo = W_O + (size_t)bi * 1024 * 1024;
                EpiResid E{HF, nullptr, attn_bo + (size_t)bi * D};
                pg8::Gemm g{OB, Wo, D, D, D, 256, 0};
                pg8::StaticOrder S; S.init(64, 4, G, bx);
                pg8::gemm_phase(lds, g, S, E);
                for (int piece = bx; piece < 160; piece += G) {
                    const int rg = piece >> 4, cgp = piece & 15, row0 = MAINROWS + rg * 16, col0 = cgp * 64;
                    small_piece(lds, OB + (size_t)row0 * D, D, Wo + (size_t)col0 * D, D, D, row0, col0, E);
                }
            }
            xcd_barrier(xbar);
        }
        for (int pass = 0; pass < 2; ++pass) {
            if (pass == 1) {
                {
                    EpiFfnIn E{HMID, ffn_convw + (size_t)layer * 3 * FF, ffn_convb + (size_t)layer * FF, state_conv + (size_t)layer * 128 * 2 * FF,
                               out + O_CP + (size_t)layer * 2 * 2 * FF, out + O_CS + (size_t)layer * 128 * 2 * FF, (LAS float*)(lds + EXCH_OFF)};
                    pg8::Gemm g{HB - (size_t)2 * D, W_IN + (size_t)layer * 5632 * 1024, D, D, D, 254, 0};
                    pg8::StaticOrder S; S.init(66, 22, G, bx);
                    pg8::gemm_phase(lds, g, S, E);
                }
                xcd_barrier(xbar);
                {
                    const bf16_t* Wo = W_OUT + (size_t)layer * 1024 * 2816;
                    EpiResid E{HF, nullptr, nullptr};
                    pg8::Gemm g{HMID, Wo, FF, FF, FF, 256, 0};
                    pg8::StaticOrder S; S.init(64, 4, G, bx);
                    pg8::gemm_phase(lds, g, S, E);
                    for (int piece = bx; piece < 160; piece += G) {
                        const int rg = piece >> 4, cgp = piece & 15, row0 = MAINROWS + rg * 16, col0 = cgp * 64;
                        small_piece(lds, HMID + (size_t)row0 * FF, FF, Wo + (size_t)col0 * FF, FF, FF, row0, col0, E);
                    }
                }
                xcd_barrier(xbar);
            }
            PHASE_IDS;
            const float* gam = (pass == 0 ? ln_mix_g : ln_ffn_g) + (size_t)layer * D; const float* bet = (pass == 0 ? ln_mix_b : ln_ffn_b) + (size_t)layer * D;
            const bool fin = (layer == 3 && pass == 1);
            f32x4 gv[4], bv[4];
#pragma unroll
            for (int j = 0; j < 4; ++j) { gv[j] = *((const f32x4*)gam + lane + 64 * j); bv[j] = *((const f32x4*)bet + lane + 64 * j); }
            for (int row = gw; row < NROWS; row += NGW) {
                f32x4* xr = (f32x4*)(HF + (size_t)row * D) + lane;
                f32x4 v[4]; float sm = 0.f;
#pragma unroll
                for (int j = 0; j < 4; ++j) { v[j] = xr[64 * j]; sm += (v[j][0] + v[j][1]) + (v[j][2] + v[j][3]); }
                const float mean = wave_sum(sm) * (1.f / D); float s2 = 0.f;
#pragma unroll
                for (int j = 0; j < 4; ++j) { v[j] = v[j] - mean; s2 += (v[j][0] * v[j][0] + v[j][1] * v[j][1]) + (v[j][2] * v[j][2] + v[j][3] * v[j][3]); }
                const float rstd = 1.f / sqrtf(wave_sum(s2) * (1.f / D) + LN_EPS);
                float* yo = nullptr;
                if (fin) { if (row < NPR) { const int b = row >= LP ? 1 : 0, p = row - b * LP; if (p >= 16) yo = out + O_YP + ((size_t)b * 8192 + (p - 16)) * D; } else yo = out + O_YS + (size_t)(row - NPR) * D; }
#pragma unroll
                for (int j = 0; j < 4; ++j) {
                    const f32x4 y = v[j] * rstd * gv[j] + bv[j];
                    xr[64 * j] = y;
                    u32x2 o; o.x = pk2(y[0], y[1]); o.y = pk2(y[2], y[3]);
                    *((u32x2*)(HB + (size_t)row * D) + lane + 64 * j) = o;
                    if (yo) *((f32x4*)yo + lane + 64 * j) = y;
                }
            }
            xcd_barrier(xbar);
        }
        if (layer == 1) {
            {
                EpiK E{KB, b_kv, out};
                pg8::Gemm g{HB, W_KV, D, D, D, 256, 0};
                pg8::StaticOrder S; S.init(65, 1, G, bx);
                pg8::gemm_phase(lds, g, S, E);
            }
            {
                EpiVt E{VT, b_kv + 256, out};
                pg8::Gemm g{W_KV + (size_t)256 * D, HB, D, D, D, 256, 0};
                pg8::StaticOrder S; S.init(1, 65, G, (bx + G - 128 % G) % G);
                pg8::gemm_phase(lds, g, S, E);
            }
            xcd_barrier(xbar);
        }
    }
}

extern "C" void kernel_launch(void* const* d_in, const int* in_sizes, int n_in, void* d_out, int out_size, void* d_ws, size_t ws_size, hipStream_t stream) {
    static int grid_blocks = 0;
    if (grid_blocks == 0) {
        if (n_in != 24 || (size_t)out_size != O_END || ws_size < WS_END) { fprintf(stderr, "kernel_launch: unexpected shapes: n_in %d out %d ws %zu (need %zu)\n", n_in, out_size, ws_size, (size_t)WS_END); grid_blocks = -1; return; }
        int dev = 0, cus = 0, per_cu = 0;
        hipGetDevice(&dev);
        hipDeviceGetAttribute(&cus, hipDeviceAttributeMultiprocessorCount, dev);
        if (hipFuncSetAttribute((const void*)mega, hipFuncAttributeMaxDynamicSharedMemorySize, LDS_BYTES) != hipSuccess) { fprintf(stderr, "kernel_launch: hipFuncSetAttribute failed\n"); grid_blocks = -1; return; }
        if (hipOccupancyMaxActiveBlocksPerMultiprocessor(&per_cu, (const void*)mega, 512, LDS_BYTES) != hipSuccess || per_cu < 1) { fprintf(stderr, "kernel_launch: occupancy query says %d blocks/CU\n", per_cu); (void)hipGetLastError(); grid_blocks = -1; return; }
        grid_blocks = cus;
    }
    if (grid_blocks < 0) return;
    if (hipMemsetAsync(d_ws, 0, CTL_BYTES, stream) != hipSuccess) { fprintf(stderr, "kernel_launch: memset failed\n"); return; }
    Args a{};
    for (int i = 0; i < 24; ++i) a.in[i] = (const float*)d_in[i];
    a.out = (float*)d_out; a.ws = (unsigned char*)d_ws;
    void* args[] = {&a};
    hipError_t e = hipLaunchCooperativeKernel((const void*)mega, dim3(grid_blocks), dim3(512), args, LDS_BYTES, stream);
    if (e != hipSuccess) fprintf(stderr, "cooperative launch failed: %s (grid %d)\n", hipGetErrorString(e), grid_blocks);
}
```

```cpp
#include <hip/hip_runtime.h>
#include <hip/hip_cooperative_groups.h>
#include <cstdio>
#include <cstdint>
namespace cg = cooperative_groups;

#define LAS __attribute__((address_space(3)))
typedef unsigned short bf16_t;
typedef short bf16x8 __attribute__((ext_vector_type(8)));
typedef short s16x4 __attribute__((ext_vector_type(4)));
typedef float f32x4 __attribute__((ext_vector_type(4)));
typedef float f32x16 __attribute__((ext_vector_type(16)));
typedef unsigned u32x4 __attribute__((ext_vector_type(4)));
typedef unsigned u32x2 __attribute__((ext_vector_type(2)));

constexpr int D = 1024, FF = 2816, LP = 8208  , NPR = 2 * LP  , NS = 128, NROWS = NPR + NS  ;
constexpr int RA = 16896;
constexpr int MAINROWS = 16384;
constexpr int KVROWS = 16640;
constexpr float ALPHA = 1.6817928305074290f;
constexpr float LN_EPS = 1e-5f;
constexpr float LOG2E = 1.4426950408889634f;

constexpr size_t O_YP = 0, O_YS = O_YP + (size_t)2 * 8192 * 1024, O_PP = O_YS + (size_t)128 * 1024, O_PS = O_PP + (size_t)2 * 2 * 15 * 1024,
                 O_CP = O_PS + (size_t)2 * 128 * 15 * 1024, O_CS = O_CP + (size_t)4 * 2 * 2 * FF, O_KP = O_CS + (size_t)4 * 128 * 2 * FF,
                 O_VP = O_KP + (size_t)2 * 128 * 256, O_KS = O_VP + (size_t)2 * 128 * 256, O_VS = O_KS + (size_t)128 * 128 * 256, O_END = O_VS + (size_t)128 * 128 * 256;

constexpr size_t MiB = 1u << 20;
constexpr size_t WS_WIN = 1 * MiB;
constexpr size_t WS_WOUT = WS_WIN + (size_t)4 * 5632 * 1024 * 2;
constexpr size_t WS_WQ = WS_WOUT + (size_t)4 * 1024 * 2816 * 2;
constexpr size_t WS_WO = WS_WQ + (size_t)2 * 1024 * 1024 * 2;
constexpr size_t WS_WKV = WS_WO + (size_t)2 * 1024 * 1024 * 2;
constexpr size_t WS_WPOOL = WS_WKV + (size_t)512 * 1024 * 2;
constexpr size_t WS_HF = WS_WPOOL + (size_t)8 * 256 * 256 * 2;
constexpr size_t WS_HB = WS_HF + (size_t)RA * 1024 * 4;
constexpr size_t WS_HMID = WS_HB + (size_t)(RA + 8) * 1024 * 2;
constexpr size_t WS_Q = WS_HMID;
constexpr size_t WS_O = WS_HMID + (size_t)RA * 1024 * 2;
constexpr size_t WS_KB = WS_HMID + (size_t)RA * FF * 2;
constexpr size_t WS_VT = WS_KB + (size_t)KVROWS * 256 * 2;
constexpr size_t WS_END = WS_VT + (size_t)KVROWS * 256 * 2;
static_assert(WS_O + (size_t)RA * 1024 * 2 <= WS_KB, "overlay");

constexpr int STAGE_LDS = 131072, EXCH_OFF = STAGE_LDS, MISC_OFF = EXCH_OFF + 4096, LDS_BYTES = 147456;
constexpr size_t CTL_BYTES = 16384;

__device__ __forceinline__ unsigned f2bf(float f) { unsigned u = __builtin_bit_cast(unsigned, f); return (u + 0x7fffu + ((u >> 16) & 1u)) >> 16; }
__device__ __forceinline__ unsigned pk2(float lo, float hi) { return f2bf(lo) | (f2bf(hi) << 16); }
__device__ __forceinline__ float bf2f(bf16_t v) { return __builtin_bit_cast(float, (unsigned)v << 16); }
__device__ __forceinline__ float wave_sum(float v) {
#pragma unroll
    for (int o = 1; o < 64; o <<= 1) v += __shfl_xor(v, o);
    return v;
}
__device__ __forceinline__ float wave_max(float v) {
#pragma unroll
    for (int o = 1; o < 64; o <<= 1) v = fmaxf(v, __shfl_xor(v, o));
    return v;
}
__device__ __forceinline__ float rdlane(float v, int l) { return __builtin_bit_cast(float, __builtin_amdgcn_readlane(__builtin_bit_cast(int, v), l)); }

__device__ __forceinline__ int launder_v(int x) { asm volatile("" : "+v"(x)); return x; }
__device__ __forceinline__ int launder_s(int x) { asm volatile("" : "+s"(x)); return x; }
namespace pg8 {
constexpr int BM = 256, BK = 64, HALF = 128, HTB = HALF * BK * 2, NXCD = 8, WGM = 8;
__device__ __forceinline__ int lds_byte(int r, int c) { const int st = (r >> 4) * 2 + (c >> 5), rr = r & 15, cc = c & 31, ob = rr * 64 + cc * 2; return st * 1024 + (ob ^ (((ob >> 9) & 1) << 5)); }
__device__ __forceinline__ void stage_rc(int b, int& R, int& C) { const int st = b / 1024, sb = b % 1024, swz = sb ^ (((sb >> 9) & 1) << 5); R = (st >> 1) * 16 + swz / 64; C = (st & 1) * 32 + (swz % 64) / 2; }
struct Unit { int pm, pn; };
struct Gemm { const bf16_t* A; const bf16_t* Bt; int lda, ldb, K, a_rows, a_pn_bytes; };
struct StaticOrder {
    int nM, nN, nwg, G, c;
    __device__ void init(int nM_, int nN_, int G_, int c_) { nM = nM_; nN = nN_; nwg = nM * nN; G = G_; c = c_; }
    __device__ bool next(int i, Unit& u) const {
        const long L = (long)i * G + c; if (L >= nwg) return false;
        int wgid = (int)L; { const int q = nwg / NXCD, r = nwg % NXCD, xcd = wgid % NXCD, off = wgid / NXCD; wgid = (xcd < r ? xcd * (q + 1) : r * (q + 1) + (xcd - r) * q) + off; }
        const int nig = WGM * nN, gid = wgid / nig, fm = gid * WGM, gsz = (nM - fm) < WGM ? (nM - fm) : WGM;
        u.pm = fm + ((wgid % nig) % gsz); u.pn = (wgid % nig) / gsz; return true;
    }
};

template <class Epi, class Sched>
__device__ __forceinline__ void gemm_phase(LAS unsigned char* lds, const Gemm g, const Sched& S, const Epi& E) {
    const int tid = launder_v(threadIdx.x), wid = __builtin_amdgcn_readfirstlane(tid >> 6), lane = tid & 63, wr = wid >> 2, wc = wid & 3, fr = lane & 15, fq = lane >> 4;
    const int K = g.K, nt = K / BK;
    unsigned voffA[2], voffB[2];
#pragma unroll
    for (int i = 0; i < 2; ++i) { int R, C; stage_rc(tid * 16 + i * 8192, R, C); voffA[i] = (unsigned)(R * g.lda + C) * 2u; voffB[i] = (unsigned)(R * g.ldb + C) * 2u; }
    const size_t kstep = (size_t)(BK * 2);
    const size_t hstepA = (size_t)HALF * g.lda * 2, hstepB = (size_t)HALF * g.ldb * 2;
    const size_t tstepA = (size_t)g.a_rows * g.lda * 2, tstepB = (size_t)BM * g.ldb * 2;
    const unsigned ldsw = (unsigned)wid * 1024u;
    const int aoff = lds_byte(wr * 64 + fr, fq * 8), boff = lds_byte(wc * 32 + fr, fq * 8);
#define PG8_SA(b, h) (((b) * 2 + (h)) * HTB)
#define PG8_SB(b, h) ((4 + (b) * 2 + (h)) * HTB)
#define PG8_STAGE(bufoff, gbase, voff) do { _Pragma("unroll") for (int _i = 0; _i < 2; ++_i) \
        __builtin_amdgcn_global_load_lds((const unsigned*)((const char*)(gbase) + (voff)[_i]), (LAS unsigned*)(lds + (bufoff) + ldsw + _i * 8192), 16, 0, 0); } while (0)
#define PG8_LDA(dst, b, h) do { _Pragma("unroll") for (int m = 0; m < 4; ++m) _Pragma("unroll") for (int k = 0; k < 2; ++k) dst[m][k] = *(const LAS bf16x8*)(lds + PG8_SA(b, h) + aoff + m * 2048 + k * 1024); } while (0)
#define PG8_LDB(dst, b, h) do { _Pragma("unroll") for (int n = 0; n < 2; ++n) _Pragma("unroll") for (int k = 0; k < 2; ++k) dst[n][k] = *(const LAS bf16x8*)(lds + PG8_SB(b, h) + boff + n * 2048 + k * 1024); } while (0)
#define PG8_MMA(ai, bj, At, Bt) do { __builtin_amdgcn_s_setprio(1); _Pragma("unroll") for (int m = 0; m < 4; ++m) _Pragma("unroll") for (int n = 0; n < 2; ++n) _Pragma("unroll") for (int k = 0; k < 2; ++k) \
        acc[ai][bj][m][n] = __builtin_amdgcn_mfma_f32_16x16x32_bf16(Bt[n][k], At[m][k], acc[ai][bj][m][n], 0, 0, 0); __builtin_amdgcn_s_setprio(0); } while (0)
#define PG8_WAIT_V(n) asm volatile("s_waitcnt vmcnt(" #n ")" ::: "memory")
#define PG8_WAIT_L(n) asm volatile("s_waitcnt lgkmcnt(" #n ")" ::: "memory")
#define PG8_BAR __builtin_amdgcn_s_barrier()
#define PG8_SCHED __builtin_amdgcn_sched_barrier(0)
    Unit cur, nxt; int ui = 0;
    if (!S.next(0, cur)) return;
    f32x4 acc[2][2][4][2];
#pragma unroll
    for (int a = 0; a < 2; ++a)
#pragma unroll
        for (int b = 0; b < 2; ++b)
#pragma unroll
            for (int m = 0; m < 4; ++m)
#pragma unroll
                for (int n = 0; n < 2; ++n) acc[a][b][m][n] = (f32x4){0.f, 0.f, 0.f, 0.f};
    bf16x8 At[4][2], B0[2][2], B1[2][2];
    const char* cA = (const char*)g.A + (size_t)cur.pm * tstepA + (size_t)cur.pn * g.a_pn_bytes; const char* cB = (const char*)g.Bt + (size_t)cur.pn * tstepB;
    PG8_STAGE(PG8_SB(0, 0), cB, voffB); PG8_STAGE(PG8_SB(0, 1), cB + hstepB, voffB); PG8_STAGE(PG8_SA(0, 0), cA, voffA); PG8_STAGE(PG8_SA(0, 1), cA + hstepA, voffA);
    if (wr == 1) PG8_BAR;
    PG8_WAIT_V(2); PG8_BAR;
    PG8_STAGE(PG8_SB(1, 0), cB + kstep, voffB); PG8_STAGE(PG8_SA(1, 0), cA + kstep, voffA); PG8_STAGE(PG8_SB(1, 1), cB + hstepB + kstep, voffB);
    PG8_WAIT_V(6); PG8_BAR;
    for (;;) {
        const bool has_next = S.next(ui + 1, nxt);
        const char* nA = has_next ? (const char*)g.A + (size_t)nxt.pm * tstepA + (size_t)nxt.pn * g.a_pn_bytes : cA; const char* nB = has_next ? (const char*)g.Bt + (size_t)nxt.pn * tstepB : cB;
        for (int t = 0; t < nt; t += 2) {
            const bool last = (t == nt - 2);
            const char* a1 = cA + (size_t)(t + 1) * kstep;
            const char* a2 = last ? nA : cA + (size_t)(t + 2) * kstep; const char* b2 = last ? nB : cB + (size_t)(t + 2) * kstep;
            const char* a3 = a2 + kstep; const char* b3 = b2 + kstep;
            PG8_LDB(B0, 0, 0); PG8_LDB(B1, 0, 1); PG8_SCHED; PG8_LDA(At, 0, 0); PG8_STAGE(PG8_SA(1, 1), a1 + hstepA, voffA);
            PG8_WAIT_V(8); PG8_WAIT_L(0); PG8_BAR; PG8_MMA(0, 0, At, B0); PG8_MMA(0, 1, At, B1); PG8_BAR; PG8_SCHED;
            PG8_LDA(At, 0, 1); PG8_STAGE(PG8_SB(0, 0), b2, voffB); PG8_STAGE(PG8_SB(0, 1), b2 + hstepB, voffB); PG8_STAGE(PG8_SA(0, 0), a2, voffA);
            PG8_WAIT_V(8); PG8_WAIT_L(0); PG8_BAR; PG8_MMA(1, 0, At, B0); PG8_MMA(1, 1, At, B1); PG8_BAR; PG8_SCHED;
            PG8_LDB(B0, 1, 0); PG8_LDB(B1, 1, 1); PG8_SCHED; PG8_LDA(At, 1, 0); PG8_STAGE(PG8_SA(0, 1), a2 + hstepA, voffA);
            PG8_WAIT_V(8); PG8_WAIT_L(0); PG8_BAR; PG8_MMA(0, 0, At, B0); PG8_MMA(0, 1, At, B1); PG8_BAR; PG8_SCHED;
            PG8_LDA(At, 1, 1); PG8_STAGE(PG8_SB(1, 0), b3, voffB); PG8_STAGE(PG8_SB(1, 1), b3 + hstepB, voffB); PG8_STAGE(PG8_SA(1, 0), a3, voffA);
            PG8_WAIT_V(8); PG8_WAIT_L(0); PG8_BAR; PG8_MMA(1, 0, At, B0); PG8_MMA(1, 1, At, B1); PG8_BAR; PG8_SCHED;
        }
        if (wr == 0) PG8_BAR;
        E(acc, cur, wr, wc, fr, fq);
        if (!has_next) break;
#pragma unroll
        for (int a = 0; a < 2; ++a)
#pragma unroll
            for (int b = 0; b < 2; ++b)
#pragma unroll
                for (int m = 0; m < 4; ++m)
#pragma unroll
                    for (int n = 0; n < 2; ++n) acc[a][b][m][n] = (f32x4){0.f, 0.f, 0.f, 0.f};
        cur = nxt; cA = nA; cB = nB; ++ui;
        if (wr == 1) PG8_BAR;
    }
    PG8_WAIT_V(0);
    PG8_BAR;
#undef PG8_SA
#undef PG8_SB
#undef PG8_STAGE
#undef PG8_LDA
#undef PG8_LDB
#undef PG8_MMA
#undef PG8_WAIT_V
#undef PG8_WAIT_L
#undef PG8_BAR
#undef PG8_SCHED
}
}


#define XB_TMO      128
#define XB_XCNT(j)  (256  + 64 * (j))
#define XB_XSUB(j)  (1280 + 64 * (j))
#define XB_XGEN(j)  (2304 + 64 * (j))
#define XB_TOP      3328
#define XB_TOPGEN   3392
#define XCD_BAR_WORDS 3456
#define XB_SPIN_CAP (1u << 18)
__device__ __forceinline__ unsigned xb_ld(unsigned* p)              { return __hip_atomic_load(p, __ATOMIC_RELAXED, __HIP_MEMORY_SCOPE_AGENT); }
__device__ __forceinline__ unsigned xb_add(unsigned* p, unsigned v) { return __hip_atomic_fetch_add(p, v, __ATOMIC_RELAXED, __HIP_MEMORY_SCOPE_AGENT); }
__device__ __forceinline__ unsigned xb_xcc_id() { return (unsigned)__builtin_amdgcn_s_getreg((3 << 11) | 20) & 0xFu; }
#define XB_SPIN(cond, bar) do { unsigned _sp = 0; while (cond) { __builtin_amdgcn_s_sleep(1); \
    if ((++_sp & 255u) == 0u) { if (xb_ld(&(bar)[XB_TMO])) break; if (_sp > XB_SPIN_CAP) { atomicAdd(&(bar)[XB_TMO], 1u); break; } } } } while (0)
struct XcdBarrier { unsigned* bar; unsigned x; volatile LAS unsigned* st; };
__device__ __forceinline__ XcdBarrier xcd_barrier_post(unsigned* bar, volatile LAS unsigned* st) {
    XcdBarrier b; b.bar = bar; b.x = xb_xcc_id(); b.st = st;
    if (threadIdx.x == 0) (void)xb_add(&bar[XB_XCNT(b.x)], 1u);
    return b;
}
__device__ __forceinline__ void xcd_barrier_complete(unsigned* bar, unsigned x, unsigned& nloc, unsigned& nx) {
    const unsigned G = gridDim.x * gridDim.y * gridDim.z;
    unsigned sum, cnt, mine, sp = 0u;
    for (;;) {
        sum = 0u; cnt = 0u; mine = 0u;
#pragma unroll
        for (unsigned j = 0; j < 16; ++j) { const unsigned c = xb_ld(&bar[XB_XCNT(j)]); sum += c; cnt += (c > 0u) ? 1u : 0u; mine = (j == x) ? c : mine; }
        if (sum == G) break;
        __builtin_amdgcn_s_sleep(1);
        if ((++sp & 255u) == 0u) { if (xb_ld(&bar[XB_TMO])) break; if (sp > XB_SPIN_CAP) { atomicAdd(&bar[XB_TMO], 1u); break; } }
    }
    nloc = mine > 0u ? mine : 1u; nx = cnt > 0u ? cnt : 1u;
}
__device__ __forceinline__ void xcd_barrier(const XcdBarrier& b) {
    asm volatile("s_waitcnt vmcnt(0)" ::: "memory");
    __syncthreads();
    if (threadIdx.x == 0) {
        unsigned* bar = b.bar;
        __builtin_amdgcn_s_waitcnt(0);
        unsigned nloc = b.st[0], nx = b.st[1];
        if (nloc == 0u) { xcd_barrier_complete(bar, b.x, nloc, nx); b.st[0] = nloc; b.st[1] = nx; }
        const unsigned old = xb_add(&bar[XB_XSUB(b.x)], 1u);
        const unsigned gen = old / nloc;
        if (old + 1u == (gen + 1u) * nloc) {
            __builtin_amdgcn_fence(__ATOMIC_RELEASE, "agent");
            asm volatile("s_waitcnt vmcnt(0)" ::: "memory");
            const unsigned og = xb_add(&bar[XB_TOP], 1u);
            const unsigned tg = og / nx;
            if (og + 1u == (tg + 1u) * nx) xb_add(&bar[XB_TOPGEN], 1u);
            else XB_SPIN(xb_ld(&bar[XB_TOPGEN]) == tg, bar);
            __builtin_amdgcn_fence(__ATOMIC_ACQUIRE, "agent");
            xb_add(&bar[XB_XGEN(b.x)], 1u);
            asm volatile("s_waitcnt vmcnt(0)" ::: "memory");
        } else {
            XB_SPIN(xb_ld(&bar[XB_XGEN(b.x)]) == gen, bar);
            __builtin_amdgcn_fence(__ATOMIC_ACQUIRE, "agent");
            asm volatile("s_waitcnt vmcnt(0)" ::: "memory");
        }
    }
    __syncthreads();
}

typedef f32x4 AccT[2][2][4][2];

struct EpiResid {
    float* hf; const float* colscale; const float* bias;
    __device__ __forceinline__ void operator()(const AccT& acc, const pg8::Unit& u, int wr, int wc, int fr_, int fq_) const {
        const int fr = launder_v(fr_), fq = launder_v(fq_);
#pragma unroll
        for (int bj = 0; bj < 2; ++bj)
#pragma unroll
            for (int n = 0; n < 2; ++n) {
                const int c = u.pn * 256 + bj * 128 + wc * 32 + n * 16 + fq * 4;
                const f32x4 cs = colscale ? *(const f32x4*)(colscale + c) : (f32x4){1.f, 1.f, 1.f, 1.f};
                const f32x4 bv = bias ? *(const f32x4*)(bias + c) : (f32x4){0.f, 0.f, 0.f, 0.f};
#pragma unroll
                for (int ai = 0; ai < 2; ++ai)
#pragma unroll
                    for (int m = 0; m < 4; ++m) {
                        const int r = u.pm * 256 + ai * 128 + wr * 64 + m * 16 + fr;
                        f32x4* p = (f32x4*)(hf + (size_t)r * D + c);
                        *p = *p * ALPHA + (acc[ai][bj][m][n] * cs + bv);
                    }
            }
    }
    __device__ __forceinline__ void elem(int r, int c, float v) const {
        const float cs = colscale ? colscale[c] : 1.f, bv = bias ? bias[c] : 0.f;
        float* p = hf + (size_t)r * D + c; *p = *p * ALPHA + (v * cs + bv);
    }
};
struct EpiQ {
    bf16_t* Q; const float* bq;
    __device__ __forceinline__ void operator()(const AccT& acc, const pg8::Unit& u, int wr, int wc, int fr_, int fq_) const {
        const int fr = launder_v(fr_), fq = launder_v(fq_);
#pragma unroll
        for (int bj = 0; bj < 2; ++bj)
#pragma unroll
            for (int n = 0; n < 2; ++n) {
                const int c = u.pn * 256 + bj * 128 + wc * 32 + n * 16 + fq * 4;
                const f32x4 bv = *(const f32x4*)(bq + c);
#pragma unroll
                for (int ai = 0; ai < 2; ++ai)
#pragma unroll
                    for (int m = 0; m < 4; ++m) {
                        const int r = u.pm * 256 + ai * 128 + wr * 64 + m * 16 + fr;
                        const f32x4 v = (acc[ai][bj][m][n] + bv) * 0.125f;
                        u32x2 w; w.x = pk2(v[0], v[1]); w.y = pk2(v[2], v[3]);
                        *(u32x2*)(Q + (size_t)r * D + c) = w;
                    }
            }
    }
    __device__ __forceinline__ void elem(int r, int c, float v) const { Q[(size_t)r * D + c] = (bf16_t)f2bf((v + bq[c]) * 0.125f); }
};
struct EpiK {
    bf16_t* KB; const float* bk; float* out;
    __device__ __forceinline__ void operator()(const AccT& acc, const pg8::Unit& u, int wr, int wc, int fr_, int fq_) const {
        const int fr = launder_v(fr_), fq = launder_v(fq_);
#pragma unroll
        for (int bj = 0; bj < 2; ++bj)
#pragma unroll
            for (int n = 0; n < 2; ++n) {
                const int c = bj * 128 + wc * 32 + n * 16 + fq * 4;
                const f32x4 bv = *(const f32x4*)(bk + c);
#pragma unroll
                for (int ai = 0; ai < 2; ++ai)
#pragma unroll
                    for (int m = 0; m < 4; ++m) {
                        const int r = u.pm * 256 + ai * 128 + wr * 64 + m * 16 + fr;
                        const f32x4 v = acc[ai][bj][m][n] + bv;
                        u32x2 w; w.x = pk2(v[0], v[1]); w.y = pk2(v[2], v[3]);
                        *(u32x2*)(KB + (size_t)r * 256 + c) = w;
                        if (r < NPR) { const int b = r >= LP ? 1 : 0, p = r - b * LP; if (p >= LP - 128) *(f32x4*)(out + O_KP + ((size_t)(b * 128 + p - (LP - 128))) * 256 + c) = v; }
                        else if (r < NROWS) { *(f32x4*)(out + O_KS + ((size_t)(r - NPR) * 128 + 127) * 256 + c) = v; }
                    }
            }
    }
};
struct EpiVt {
    bf16_t* VT; const float* bv; float* out;
    __device__ __forceinline__ void operator()(const AccT& acc, const pg8::Unit& u, int wr, int wc, int fr_, int fq_) const {
        const int fr = launder_v(fr_), fq = launder_v(fq_);
#pragma unroll
        for (int ai = 0; ai < 2; ++ai)
#pragma unroll
            for (int m = 0; m < 4; ++m) {
                const int d = ai * 128 + wr * 64 + m * 16 + fr;
                const float b = bv[d];
#pragma unroll
                for (int bj = 0; bj < 2; ++bj)
#pragma unroll
                    for (int n = 0; n < 2; ++n) {
                        const int c = u.pn * 256 + bj * 128 + wc * 32 + n * 16 + fq * 4;
                        const f32x4 v = acc[ai][bj][m][n] + b;
                        u32x2 w; w.x = pk2(v[0], v[1]); w.y = pk2(v[2], v[3]);
                        *(u32x2*)(VT + (size_t)d * KVROWS + c) = w;
#pragma unroll
                        for (int j = 0; j < 4; ++j) { const int r = c + j;
                            if (r < NPR) { const int bb = r >= LP ? 1 : 0, p = r - bb * LP; if (p >= LP - 128) out[O_VP + ((size_t)(bb * 128 + p - (LP - 128))) * 256 + d] = v[j]; }
                            else if (r < NROWS) out[O_VS + ((size_t)(r - NPR) * 128 + 127) * 256 + d] = v[j]; }
                    }
            }
    }
};
struct EpiFfnIn {
    bf16_t* hmid; const float* convw; const float* convb; const float* state_conv; float* out_cp; float* out_cs; LAS float* exch;
    __device__ __forceinline__ void operator()(const AccT& acc, const pg8::Unit& u, int wr, int wc, int fr_, int fq_) const {
        const int fr = launder_v(fr_), fq = launder_v(fq_);
        const int lane = fq * 16 + fr;
        if (fr >= 14) {
#pragma unroll
            for (int ai = 0; ai < 2; ++ai)
#pragma unroll
                for (int n = 0; n < 2; ++n) *(LAS f32x4*)(exch + ((ai * 2 + wr) * 2 + (fr - 14)) * 128 + wc * 32 + n * 16 + fq * 4) = acc[ai][0][3][n];
        }
        asm volatile("s_waitcnt lgkmcnt(0)" ::: "memory"); __builtin_amdgcn_s_barrier(); asm volatile("" ::: "memory");
        const int src1 = (lane & 48) | ((fr + 15) & 15), src2 = (lane & 48) | ((fr + 14) & 15);
#pragma unroll
        for (int n = 0; n < 2; ++n) {
            const int ff = u.pn * 128 + wc * 32 + n * 16 + fq * 4;
            const f32x4 w0 = *(const f32x4*)(convw + ff), w1 = *(const f32x4*)(convw + FF + ff), w2 = *(const f32x4*)(convw + 2 * FF + ff), cb = *(const f32x4*)(convb + ff);
#pragma unroll
            for (int ai = 0; ai < 2; ++ai) {
                const int pbi = ai * 2 + wr - 1;
                f32x4 e14 = (f32x4){0.f, 0.f, 0.f, 0.f}, e15 = e14;
                if (pbi >= 0) { e14 = *(const LAS f32x4*)(exch + (pbi * 2 + 0) * 128 + wc * 32 + n * 16 + fq * 4); e15 = *(const LAS f32x4*)(exch + (pbi * 2 + 1) * 128 + wc * 32 + n * 16 + fq * 4); }
#pragma unroll
                for (int m = 0; m < 4; ++m) {
                    const int r_loc = ai * 128 + wr * 64 + m * 16 + fr; const int R = u.pm * 254 - 2 + r_loc;
                    const f32x4 g0 = acc[ai][0][m][n], uu = acc[ai][1][m][n];
                    f32x4 x1, x2;
                    if (m == 0) { x1 = g0; x2 = g0; } else { const f32x4 gp = acc[ai][0][m == 0 ? 0 : m - 1][n]; x1 = (fr == 15) ? gp : g0; x2 = (fr >= 14) ? gp : g0; }
                    f32x4 p1, p2;
#pragma unroll
                    for (int j = 0; j < 4; ++j) { p1[j] = __shfl(x1[j], src1); p2[j] = __shfl(x2[j], src2); }
                    if (m == 0) { if (fr == 0) { p1 = e15; p2 = e14; } else if (fr == 1) { p2 = e15; } }
                    const bool valid = (r_loc >= 2) && (R < NROWS);
                    if (valid) {
                        if (R < NPR) {
                            const int b = R >= LP ? 1 : 0, p = R - b * LP;
                            if (p < 1) p1 = (f32x4){0.f, 0.f, 0.f, 0.f};
                            if (p < 2) p2 = (f32x4){0.f, 0.f, 0.f, 0.f};
                            if (p >= LP - 2) *(f32x4*)(out_cp + ((size_t)(b * 2 + (p - (LP - 2)))) * FF + ff) = g0;
                        } else {
                            const int s = R - NPR;
                            p2 = *(const f32x4*)(state_conv + ((size_t)s * 2 + 0) * FF + ff);
                            p1 = *(const f32x4*)(state_conv + ((size_t)s * 2 + 1) * FF + ff);
                            *(f32x4*)(out_cs + ((size_t)s * 2 + 0) * FF + ff) = p1;
                            *(f32x4*)(out_cs + ((size_t)s * 2 + 1) * FF + ff) = g0;
                        }
                        const f32x4 c = cb + w0 * p2 + w1 * p1 + w2 * g0;
                        f32x4 h;
#pragma unroll
                        for (int j = 0; j < 4; ++j) h[j] = c[j] * __builtin_amdgcn_rcpf(1.f + __builtin_amdgcn_exp2f(-c[j] * LOG2E)) * uu[j];
                        u32x2 w; w.x = pk2(h[0], h[1]); w.y = pk2(h[2], h[3]);
                        *(u32x2*)(hmid + (size_t)R * FF + ff) = w;
                    }
                }
            }
        }
    }
};

template <class Epi>
__device__ __forceinline__ void small_piece(LAS unsigned char* lds, const bf16_t* A, int lda, const bf16_t* Bt, int ldb, int K, int row0, int col0, const Epi& E) {
    const int tid = launder_v(threadIdx.x), wid = __builtin_amdgcn_readfirstlane(tid >> 6), lane = tid & 63, fr = lane & 15, fq = lane >> 4;
    const int kw = K / 8, k0 = wid * kw;
    f32x4 acc[4];
#pragma unroll
    for (int n = 0; n < 4; ++n) acc[n] = (f32x4){0.f, 0.f, 0.f, 0.f};
    for (int ks = 0; ks < kw; ks += 32) {
        const bf16x8 a = *(const bf16x8*)(A + (size_t)fr * lda + k0 + ks + fq * 8);
#pragma unroll
        for (int n = 0; n < 4; ++n) {
            const bf16x8 b = *(const bf16x8*)(Bt + (size_t)(n * 16 + fr) * ldb + k0 + ks + fq * 8);
            acc[n] = __builtin_amdgcn_mfma_f32_16x16x32_bf16(b, a, acc[n], 0, 0, 0);
        }
    }
    LAS float* red = (LAS float*)lds;
#pragma unroll
    for (int n = 0; n < 4; ++n) *(LAS f32x4*)(red + wid * 1024 + fr * 64 + n * 16 + fq * 4) = acc[n];
    __syncthreads();
#pragma unroll
    for (int i = 0; i < 2; ++i) {
        const int idx = tid + i * 512; float s = 0.f;
#pragma unroll
        for (int w = 0; w < 8; ++w) s += red[w * 1024 + idx];
        E.elem(row0 + (idx >> 6), col0 + (idx & 63), s);
    }
    __syncthreads();
}

struct Args { const float* in[24]; float* out; unsigned char* ws; };

__device__ __forceinline__ void transpose_item(const float* W, int K, int N, bf16_t* WT, int k0, int n0, int drow0, LAS float* scr, int lane) {
    float tv[32];
    const float* wp = W + (size_t)(k0 + (lane >> 5)) * N + n0 + (lane & 31);
#pragma unroll
    for (int i = 0; i < 32; ++i) tv[i] = wp[(size_t)(2 * i) * N];
#pragma unroll
    for (int i = 0; i < 32; ++i) scr[(2 * i + (lane >> 5)) * 33 + (lane & 31)] = tv[i];
    asm volatile("s_waitcnt lgkmcnt(0)" ::: "memory");
    const int c = lane & 7;
#pragma unroll
    for (int j = 0; j < 4; ++j) { const int n = (lane >> 3) + 8 * j; const LAS float* s = scr + (8 * c) * 33 + n;
        u32x4 o; o.x = pk2(s[0 * 33], s[1 * 33]); o.y = pk2(s[2 * 33], s[3 * 33]); o.z = pk2(s[4 * 33], s[5 * 33]); o.w = pk2(s[6 * 33], s[7 * 33]);
        *(u32x4*)(WT + (size_t)(drow0 + n) * K + k0 + 8 * c) = o; }
    asm volatile("s_waitcnt lgkmcnt(0)" ::: "memory");
}
__device__ __forceinline__ void transpose_matrix_item(const float* W, int K, int N, bf16_t* WT, int item, LAS float* scr, int lane, bool ffn_in) {
    const int nblk = N / 32, kb = item / nblk, nb = item % nblk, n0 = 32 * nb;
    int drow0 = n0;
    if (ffn_in) { const int isu = n0 >= FF ? 1 : 0, ff = n0 - isu * FF; drow0 = (ff >> 7) * 256 + isu * 128 + (ff & 127); }
    transpose_item(W, K, N, WT, 64 * kb, n0, drow0, scr, lane);
}

__global__ void __launch_bounds__(512, 2) mega(Args a) {
    extern __shared__ __attribute__((aligned(16))) unsigned char lds_raw[];
    LAS unsigned char* lds = (LAS unsigned char*)lds_raw;
    cg::grid_group grid = cg::this_grid();
    const int G = gridDim.x, bx = blockIdx.x, NGW = G * 8, NGT = G * 512;
#define PHASE_IDS const int tid = launder_v(threadIdx.x), lane = tid & 63, wave = __builtin_amdgcn_readfirstlane(tid >> 6), gw = bx * 8 + wave, gt = bx * 512 + tid; (void)lane; (void)gw; (void)gt; (void)wave
    unsigned char* ws = a.ws; float* out = a.out;
    if (threadIdx.x < 2) ((volatile LAS unsigned*)(lds + MISC_OFF))[threadIdx.x] = 0u;
    __syncthreads();
    const XcdBarrier xbar = xcd_barrier_post((unsigned*)ws, (volatile LAS unsigned*)(lds + MISC_OFF));
    const float* x_prompt = a.in[0]; const float* x_sample = a.in[1]; const float* state_pool = a.in[2]; const float* state_conv = a.in[3];
    const float* state_k = a.in[4]; const float* state_v = a.in[5]; const float* meta = a.in[6]; const float* pool_w = a.in[7]; const float* pool_scale = a.in[8];
    const float* w_kv = a.in[9]; const float* b_kv = a.in[10]; const float* attn_wq = a.in[11]; const float* attn_bq = a.in[12]; const float* attn_sinks = a.in[13];
    const float* attn_wo = a.in[14]; const float* attn_bo = a.in[15]; const float* ffn_win = a.in[16]; const float* ffn_convw = a.in[17]; const float* ffn_convb = a.in[18];
    const float* ffn_wout = a.in[19]; const float* ln_mix_g = a.in[20]; const float* ln_mix_b = a.in[21]; const float* ln_ffn_g = a.in[22]; const float* ln_ffn_b = a.in[23];
    bf16_t* W_IN = (bf16_t*)(ws + WS_WIN); bf16_t* W_OUT = (bf16_t*)(ws + WS_WOUT); bf16_t* W_Q = (bf16_t*)(ws + WS_WQ); bf16_t* W_O = (bf16_t*)(ws + WS_WO);
    bf16_t* W_KV = (bf16_t*)(ws + WS_WKV); bf16_t* W_POOL = (bf16_t*)(ws + WS_WPOOL);
    float* HF = (float*)(ws + WS_HF); bf16_t* HB = (bf16_t*)(ws + WS_HB) + (size_t)8 * D; bf16_t* HMID = (bf16_t*)(ws + WS_HMID);
    bf16_t* QB = (bf16_t*)(ws + WS_Q); bf16_t* OB = (bf16_t*)(ws + WS_O); bf16_t* KB = (bf16_t*)(ws + WS_KB); bf16_t* VT = (bf16_t*)(ws + WS_VT);

    {
        PHASE_IDS;
        LAS float* scr = (LAS float*)(lds + wave * 16384);
        constexpr int I_IN = (1024 / 64) * (5632 / 32), I_OUT = (2816 / 64) * (1024 / 32), I_SQ = 16 * 32, I_KV = 16 * 16, I_PL = 4 * 8;
        constexpr int NITEMS = 4 * I_IN + 4 * I_OUT + 4 * I_SQ + I_KV + 8 * I_PL;
        for (int it = gw; it < NITEMS; it += NGW) {
            int r = it;
            if (r < 4 * I_IN) { const int l = r / I_IN; transpose_matrix_item(ffn_win + (size_t)l * 1024 * 5632, 1024, 5632, W_IN + (size_t)l * 5632 * 1024, r % I_IN, scr, lane, true); continue; } r -= 4 * I_IN;
            if (r < 4 * I_OUT) { const int l = r / I_OUT; transpose_matrix_item(ffn_wout + (size_t)l * 2816 * 1024, 2816, 1024, W_OUT + (size_t)l * 1024 * 2816, r % I_OUT, scr, lane, false); continue; } r -= 4 * I_OUT;
            if (r < 2 * I_SQ) { const int l = r / I_SQ; transpose_matrix_item(attn_wq + (size_t)l * 1024 * 1024, 1024, 1024, W_Q + (size_t)l * 1024 * 1024, r % I_SQ, scr, lane, false); continue; } r -= 2 * I_SQ;
            if (r < 2 * I_SQ) { const int l = r / I_SQ; transpose_matrix_item(attn_wo + (size_t)l * 1024 * 1024, 1024, 1024, W_O + (size_t)l * 1024 * 1024, r % I_SQ, scr, lane, false); continue; } r -= 2 * I_SQ;
            if (r < I_KV) { transpose_matrix_item(w_kv, 1024, 512, W_KV, r, scr, lane, false); continue; } r -= I_KV;
            { const int l = r / I_PL; transpose_matrix_item(pool_w + (size_t)l * 65536, 256, 256, W_POOL + (size_t)l * 65536, r % I_PL, scr, lane, false); }
        }
        for (int row = gw; row < NROWS; row += NGW) {
            const float* src;
            if (row < NPR) { const int b = row >= LP ? 1 : 0, p = row - b * LP; src = p < 16 ? meta + (size_t)p * D : x_prompt + ((size_t)b * 8192 + (p - 16)) * D; }
            else src = x_sample + (size_t)(row - NPR) * D;
#pragma unroll
            for (int j = 0; j < 4; ++j) *((f32x4*)(HF + (size_t)row * D) + lane + 64 * j) = *((const f32x4*)src + lane + 64 * j);
        }
        for (int i = gt; i < 128 * 127 * 64; i += NGT) {
            const int c4 = i & 63, rr = (i >> 6) % 127, s = (i >> 6) / 127;
            *((f32x4*)(out + O_KS + ((size_t)s * 128 + rr) * 256) + c4) = *((const f32x4*)(state_k + ((size_t)s * 128 + rr + 1) * 256) + c4);
            *((f32x4*)(out + O_VS + ((size_t)s * 128 + rr) * 256) + c4) = *((const f32x4*)(state_v + ((size_t)s * 128 + rr + 1) * 256) + c4);
        }
    }
    grid.sync();

#pragma nounroll
    for (int layer_ = 0; layer_ < 4; ++layer_) {
        const int layer = launder_s(layer_);
        if (layer < 2) {
            PHASE_IDS;
            const float* sp = state_pool + (size_t)layer * 128 * 15 * D;
            for (int i = gt; i < (NPR / 8) * 256; i += NGT) {
                const int c4 = i & 255, chunk = i >> 8, gi = c4 >> 6, w = 2 << gi, row0 = chunk * 8;
                const int b = row0 >= LP ? 1 : 0, p0 = row0 - b * LP;
                f32x4 xv[23];
#pragma unroll
                for (int j = 0; j < 23; ++j) {
                    const int p = p0 - 15 + j;
                    xv[j] = (f32x4){0.f, 0.f, 0.f, 0.f};
                    if (j >= 16 - w && p >= 0) xv[j] = *((const f32x4*)(HF + (size_t)(row0 - 15 + j) * D) + c4);
                }
                f32x4 sum = (f32x4){0.f, 0.f, 0.f, 0.f};
#pragma unroll
                for (int j = 0; j < 16; ++j) sum += xv[j];
#pragma unroll
                for (int r = 0; r < 8; ++r) {
                    const int p = p0 + r;
                    if (r > 0) { sum += xv[15 + r]; f32x4 old = (f32x4){0.f, 0.f, 0.f, 0.f};
#pragma unroll
                        for (int g2 = 0; g2 < 4; ++g2) if (gi == g2) old = xv[15 + r - (2 << g2)];
                        sum -= old; }
                    const int cnt = (p + 1) < w ? (p + 1) : w;
                    const f32x4 x = xv[15 + r];
                    if (p >= LP - 15) *((f32x4*)(out + O_PP + (((size_t)layer * 2 + b) * 15 + (p - (LP - 15))) * D) + c4) = x;
                    const f32x4 dd = sum * (1.0f / (float)cnt) - x;
                    u32x2 o; o.x = pk2(dd[0], dd[1]); o.y = pk2(dd[2], dd[3]);
                    *((u32x2*)(QB + (size_t)(row0 + r) * D) + c4) = o;
                }
            }
            for (int i = gt; i < NS * 256; i += NGT) {
                const int s = i >> 8, c4 = i & 255, gi = c4 >> 6, w = 2 << gi, row = NPR + s;
                const f32x4 x = *((const f32x4*)(HF + (size_t)row * D) + c4);
                f32x4 sum = x;
                float* op = out + O_PS + (((size_t)layer * 128 + s) * 15) * D;
                *((f32x4*)(op + (size_t)14 * D) + c4) = x;
#pragma unroll
                for (int k = 1; k < 15; ++k) { const f32x4 v = *((const f32x4*)(sp + ((size_t)s * 15 + k) * D) + c4);
                    *((f32x4*)(op + (size_t)(k - 1) * D) + c4) = v; if (15 - k < w) sum += v; }
                if (w == 16) sum += *((const f32x4*)(sp + ((size_t)s * 15) * D) + c4);
                const f32x4 dd = sum * (1.0f / (float)w) - x;
                u32x2 o; o.x = pk2(dd[0], dd[1]); o.y = pk2(dd[2], dd[3]);
                *((u32x2*)(QB + (size_t)row * D) + c4) = o;
            }
            xcd_barrier(xbar);
            {
                const bf16_t* Wp = W_POOL + (size_t)layer * 4 * 65536;
                EpiResid E{HF, pool_scale + (size_t)layer * D, nullptr};
                pg8::Gemm g{QB, Wp, D, 256, 256, 256, 512};
                pg8::StaticOrder S; S.init(64, 4, G, bx);
                pg8::gemm_phase(lds, g, S, E);
                for (int piece = bx; piece < 160; piece += G) {
                    const int rg = piece >> 4, cgp = piece & 15, gi = cgp >> 2, row0 = MAINROWS + rg * 16, col0 = cgp * 64;
                    small_piece(lds, QB + (size_t)row0 * D + gi * 256, D, Wp + (size_t)gi * 65536 + (size_t)(col0 & 255) * 256, 256, 256, row0, col0, E);
                }
            }
            xcd_barrier(xbar);
        } else {
            const int bi = layer - 2;
            {
                const bf16_t* Wq = W_Q + (size_t)bi * 1024 * 1024;
                EpiQ E{QB, attn_bq + (size_t)bi * D};
                pg8::Gemm g{HB, Wq, D, D, D, 256, 0};
                pg8::StaticOrder S; S.init(64, 4, G, bx);
                pg8::gemm_phase(lds, g, S, E);
                for (int piece = bx; piece < 160; piece += G) {
                    const int rg = piece >> 4, cgp = piece & 15, row0 = MAINROWS + rg * 16, col0 = cgp * 64;
                    small_piece(lds, HB + (size_t)row0 * D, D, Wq + (size_t)col0 * D, D, D, row0, col0, E);
                }
            }
            xcd_barrier(xbar);
            {
                PHASE_IDS;
                const float* sinks = attn_sinks + bi * 16;
                for (int unit = bx; unit < 2 * 129 * 4; unit += G) {
                    const int kvh = unit & 3, bq = unit >> 2, b = bq / 129, qt = bq % 129, kbase = 64 * qt - 128;
                    for (int i = tid; i < 1536; i += 512) { const int row = i >> 3, ch = i & 7, kp = kbase + row;
                        u32x4 v = (u32x4){0u, 0u, 0u, 0u}; if (kp >= 0) v = *(const u32x4*)(KB + (size_t)(b * LP + kp) * 256 + kvh * 64 + ch * 8);
                        *(LAS u32x4*)(lds + row * 144 + ch * 16) = v; }
                    for (int i = tid; i < 1536; i += 512) { const int d = i / 24, ch = i % 24, kp = kbase + ch * 8;
                        u32x4 v = (u32x4){0u, 0u, 0u, 0u}; if (kp >= 0) v = *(const u32x4*)(VT + (size_t)(kvh * 64 + d) * KVROWS + b * LP + kp);
                        *(LAS u32x4*)(lds + 27648 + d * 400 + ch * 16) = v; }
                    __syncthreads();
                    {
                        const int hg = wave & 3, qb = wave >> 2, h = kvh * 4 + hg, q0 = 64 * qt + 32 * qb, ql = lane & 31, hi = lane >> 5;
                        const int qp = q0 + ql; const size_t qrow = (size_t)b * LP + qp;
                        bf16x8 qf[4];
#pragma unroll
                        for (int ds = 0; ds < 4; ++ds) qf[ds] = *(const bf16x8*)(QB + qrow * D + h * 64 + 16 * ds + 8 * hi);
                        f32x16 s[5];
#pragma unroll
                        for (int kbi = 0; kbi < 5; ++kbi) {
                            f32x16 acc;
#pragma unroll
                            for (int r = 0; r < 16; ++r) acc[r] = 0.f;
#pragma unroll
                            for (int ds = 0; ds < 4; ++ds) { const bf16x8 kf = *(const LAS bf16x8*)(lds + (32 * (qb + kbi) + ql) * 144 + (16 * ds + 8 * hi) * 2);
                                acc = __builtin_amdgcn_mfma_f32_32x32x16_bf16(kf, qf[ds], acc, 0, 0, 0); }
                            s[kbi] = acc;
                        }
                        const float sink = sinks[h];
                        float mx = -1e30f;
#pragma unroll
                        for (int kbi = 0; kbi < 5; ++kbi)
#pragma unroll
                            for (int r = 0; r < 16; ++r) { const int kp = kbase + 32 * (qb + kbi) + (r & 3) + 8 * (r >> 2) + 4 * hi;
                                const bool valid = (kp >= 0) && (kp <= qp) && (qp - kp < 128);
                                const float v = valid ? s[kbi][r] : -1e30f; s[kbi][r] = v; mx = fmaxf(mx, v); }
                        mx = fmaxf(mx, __shfl_xor(mx, 32)); mx = fmaxf(mx, sink);
                        float sum = 0.f;
#pragma unroll
                        for (int kbi = 0; kbi < 5; ++kbi)
#pragma unroll
                            for (int r = 0; r < 16; ++r) { const float e = __builtin_amdgcn_exp2f((s[kbi][r] - mx) * LOG2E); s[kbi][r] = e; sum += e; }
                        sum += __shfl_xor(sum, 32);
                        const float inv = 1.0f / (sum + __builtin_amdgcn_exp2f((sink - mx) * LOG2E));
                        f32x16 o[2];
#pragma unroll
                        for (int db = 0; db < 2; ++db)
#pragma unroll
                            for (int r = 0; r < 16; ++r) o[db][r] = 0.f;
#pragma unroll
                        for (int kbi = 0; kbi < 5; ++kbi)
#pragma unroll
                            for (int j = 0; j < 2; ++j) {
                                u32x4 pu;
#pragma unroll
                                for (int i = 0; i < 4; ++i) pu[i] = pk2(s[kbi][8 * j + 2 * i], s[kbi][8 * j + 2 * i + 1]);
                                const bf16x8 pbv = __builtin_bit_cast(bf16x8, pu);
#pragma unroll
                                for (int db = 0; db < 2; ++db) {
                                    const LAS unsigned char* base = lds + 27648 + (32 * db + ql) * 400 + (32 * (qb + kbi) + 16 * j + 4 * hi) * 2;
                                    const s16x4 lo = *(const LAS s16x4*)base, hh = *(const LAS s16x4*)(base + 16);
                                    const bf16x8 av = (bf16x8){lo[0], lo[1], lo[2], lo[3], hh[0], hh[1], hh[2], hh[3]};
                                    o[db] = __builtin_amdgcn_mfma_f32_32x32x16_bf16(av, pbv, o[db], 0, 0, 0);
                                }
                            }
                        if (qp < LP) {
#pragma unroll
                            for (int db = 0; db < 2; ++db)
#pragma unroll
                                for (int g4 = 0; g4 < 4; ++g4) { const int dd = 32 * db + 8 * g4 + 4 * hi;
                                    u32x2 w; w.x = pk2(o[db][4 * g4] * inv, o[db][4 * g4 + 1] * inv); w.y = pk2(o[db][4 * g4 + 2] * inv, o[db][4 * g4 + 3] * inv);
                                    *(u32x2*)(OB + qrow * D + h * 64 + dd) = w; }
                        }
                    }
                    __syncthreads();
                }
                for (int task = gw; task < 2048; task += NGW) {
                    const int s = task >> 4, h = task & 15, kvh = h >> 2; const size_t row = (size_t)NPR + s;
                    const float qv = bf2f(QB[row * D + h * 64 + lane]);
                    const int rb = (lane + 65) < 127 ? (lane + 65) : 127;
                    const f32x4* kA = (const f32x4*)(state_k + (((size_t)s * 128 + lane + 1) * 4 + kvh) * 64);
                    const f32x4* kBp = (const f32x4*)(state_k + (((size_t)s * 128 + rb) * 4 + kvh) * 64);
                    float sA = 0.f, sB = 0.f;
#pragma unroll
                    for (int d4 = 0; d4 < 16; ++d4) { const f32x4 ka = kA[d4], kb = kBp[d4];
                        const float q0 = rdlane(qv, 4 * d4), q1 = rdlane(qv, 4 * d4 + 1), q2 = rdlane(qv, 4 * d4 + 2), q3 = rdlane(qv, 4 * d4 + 3);
                        sA += ka[0] * q0 + ka[1] * q1 + ka[2] * q2 + ka[3] * q3; sB += kb[0] * q0 + kb[1] * q1 + kb[2] * q2 + kb[3] * q3; }
                    const float snew = wave_sum(bf2f(KB[row * 256 + kvh * 64 + lane]) * qv);
                    if (lane == 63) sB = snew;
                    const float sink = sinks[h];
                    const float mx = fmaxf(wave_max(fmaxf(sA, sB)), sink);
                    const float eA = __builtin_amdgcn_exp2f((sA - mx) * LOG2E), eB = __builtin_amdgcn_exp2f((sB - mx) * LOG2E);
                    const float den = wave_sum(eA + eB) + __builtin_amdgcn_exp2f((sink - mx) * LOG2E);
                    float acc = 0.f;
                    const float* vb = state_v + (((size_t)s * 128) * 4 + kvh) * 64 + lane;
#pragma unroll 16
                    for (int j = 0; j < 64; ++j) acc += rdlane(eA, j) * vb[(size_t)(j + 1) * 256];
#pragma unroll 9
                    for (int j = 0; j < 63; ++j) acc += rdlane(eB, j) * vb[(size_t)(j + 65) * 256];
                    acc += rdlane(eB, 63) * bf2f(VT[(size_t)(kvh * 64 + lane) * KVROWS + row]);
                    OB[row * D + h * 64 + lane] = (bf16_t)f2bf(acc / den);
                }
            }
            xcd_barrier(xbar);
            {
                const bf16_t* Wo = W_O + (size_t)bi * 1024 * 1024;
                EpiResid E{HF, nullptr, attn_bo + (size_t)bi * D};
                pg8::Gemm g{OB, Wo, D, D, D, 256, 0};
                pg8::StaticOrder S; S.init(64, 4, G, bx);
                pg8::gemm_phase(lds, g, S, E);
                for (int piece = bx; piece < 160; piece += G) {
                    const int rg = piece >> 4, cgp = piece & 15, row0 = MAINROWS + rg * 16, col0 = cgp * 64;
                    small_piece(lds, OB + (size_t)row0 * D, D, Wo + (size_t)col0 * D, D, D, row0, col0, E);
                }
            }
            xcd_barrier(xbar);
        }
        for (int pass = 0; pass < 2; ++pass) {
            if (pass == 1) {
                {
                    EpiFfnIn E{HMID, ffn_convw + (size_t)layer * 3 * FF, ffn_convb + (size_t)layer * FF, state_conv + (size_t)layer * 128 * 2 * FF,
                               out + O_CP + (size_t)layer * 2 * 2 * FF, out + O_CS + (size_t)layer * 128 * 2 * FF, (LAS float*)(lds + EXCH_OFF)};
                    pg8::Gemm g{HB - (size_t)2 * D, W_IN + (size_t)layer * 5632 * 1024, D, D, D, 254, 0};
                    pg8::StaticOrder S; S.init(66, 22, G, bx);
                    pg8::gemm_phase(lds, g, S, E);
                }
                xcd_barrier(xbar);
                {
                    const bf16_t* Wo = W_OUT + (size_t)layer * 1024 * 2816;
                    EpiResid E{HF, nullptr, nullptr};
                    pg8::Gemm g{HMID, Wo, FF, FF, FF, 256, 0};
                    pg8::StaticOrder S; S.init(64, 4, G, bx);
                    pg8::gemm_phase(lds, g, S, E);
                    for (int piece = bx; piece < 160; piece += G) {
                        const int rg = piece >> 4, cgp = piece & 15, row0 = MAINROWS + rg * 16, col0 = cgp * 64;
                        small_piece(lds, HMID + (size_t)row0 * FF, FF, Wo + (size_t)col0 * FF, FF, FF, row0, col0, E);
                    }
                }
                xcd_barrier(xbar);
            }
            PHASE_IDS;
            const float* gam = (pass == 0 ? ln_mix_g : ln_ffn_g) + (size_t)layer * D; const float* bet = (pass == 0 ? ln_mix_b : ln_ffn_b) + (size_t)layer * D;
            const bool fin = (layer == 3 && pass == 1);
            f32x4 gv[4], bv[4];
#pragma unroll
            for (int j = 0; j < 4; ++j) { gv[j] = *((const f32x4*)gam + lane + 64 * j); bv[j] = *((const f32x4*)bet + lane + 64 * j); }
            for (int row = gw; row < NROWS; row += NGW) {
                f32x4* xr = (f32x4*)(HF + (size_t)row * D) + lane;
                f32x4 v[4]; float sm = 0.f;
#pragma unroll
                for (int j = 0; j < 4; ++j) { v[j] = xr[64 * j]; sm += (v[j][0] + v[j][1]) + (v[j][2] + v[j][3]); }
                const float mean = wave_sum(sm) * (1.f / D); float s2 = 0.f;
#pragma unroll
                for (int j = 0; j < 4; ++j) { v[j] = v[j] - mean; s2 += (v[j][0] * v[j][0] + v[j][1] * v[j][1]) + (v[j][2] * v[j][2] + v[j][3] * v[j][3]); }
                const float rstd = 1.f / sqrtf(wave_sum(s2) * (1.f / D) + LN_EPS);
                float* yo = nullptr;
                if (fin) { if (row < NPR) { const int b = row >= LP ? 1 : 0, p = row - b * LP; if (p >= 16) yo = out + O_YP + ((size_t)b * 8192 + (p - 16)) * D; } else yo = out + O_YS + (size_t)(row - NPR) * D; }
#pragma unroll
                for (int j = 0; j < 4; ++j) {
                    const f32x4 y = v[j] * rstd * gv[j] + bv[j];
                    xr[64 * j] = y;
                    u32x2 o; o.x = pk2(y[0], y[1]); o.y = pk2(y[2], y[3]);
                    *((u32x2*)(HB + (size_t)row * D) + lane + 64 * j) = o;
                    if (yo) *((f32x4*)yo + lane + 64 * j) = y;
                }
            }
            xcd_barrier(xbar);
        }
        if (layer == 1) {
            {
                EpiK E{KB, b_kv, out};
                pg8::Gemm g{HB, W_KV, D, D, D, 256, 0};
                pg8::StaticOrder S; S.init(65, 1, G, bx);
                pg8::gemm_phase(lds, g, S, E);
            }
            {
                EpiVt E{VT, b_kv + 256, out};
                pg8::Gemm g{W_KV + (size_t)256 * D, HB, D, D, D, 256, 0};
                pg8::StaticOrder S; S.init(1, 65, G, (bx + G - 128 % G) % G);
                pg8::gemm_phase(lds, g, S, E);
            }
            xcd_barrier(xbar);
        }
    }
}

extern "C" void kernel_launch(void* const* d_in, const int* in_sizes, int n_in, void* d_out, int out_size, void* d_ws, size_t ws_size, hipStream_t stream) {
    static int grid_blocks = 0;
    if (grid_blocks == 0) {
        if (n_in != 24 || (size_t)out_size != O_END || ws_size < WS_END) { fprintf(stderr, "kernel_launch: unexpected shapes: n_in %d out %d ws %zu (need %zu)\n", n_in, out_size, ws_size, (size_t)WS_END); grid_blocks = -1; return; }
        int dev = 0, cus = 0, per_cu = 0;
        hipGetDevice(&dev);
        hipDeviceGetAttribute(&cus, hipDeviceAttributeMultiprocessorCount, dev);
        if (hipFuncSetAttribute((const void*)mega, hipFuncAttributeMaxDynamicSharedMemorySize, LDS_BYTES) != hipSuccess) { fprintf(stderr, "kernel_launch: hipFuncSetAttribute failed\n"); grid_blocks = -1; return; }
        if (hipOccupancyMaxActiveBlocksPerMultiprocessor(&per_cu, (const void*)mega, 512, LDS_BYTES) != hipSuccess || per_cu < 1) { fprintf(stderr, "kernel_launch: occupancy query says %d blocks/CU\n", per_cu); (void)hipGetLastError(); grid_blocks = -1; return; }
        grid_blocks = cus;
    }
    if (grid_blocks < 0) return;
    if (hipMemsetAsync(d_ws, 0, CTL_BYTES, stream) != hipSuccess) { fprintf(stderr, "kernel_launch: memset failed\n"); return; }
    Args a{};
    for (int i = 0; i < 24; ++i) a.in[i] = (const float*)d_in[i];
    a.out = (float*)d_out; a.ws = (unsigned char*)d_ws;
    void* args[] = {&a};
    hipError_t e = hipLaunchCooperativeKernel((const void*)mega, dim3(grid_blocks), dim3(512), args, LDS_BYTES, stream);
    if (e != hipSuccess) fprintf(stderr, "cooperative launch failed: %s (grid %d)\n", hipGetErrorString(e), grid_blocks);
}
```
